# Optimizing an MI355X kernel written in HIP

```python
import jax, jax.numpy as jnp
from jax import lax
import numpy as np

D_MODEL = 1024
BATCH = 2
SEQ = 16384
DEPTH = 4

GRID_W = 64
CTX_LEN = 256
D_MIX = D_MODEL
HEAD_DIM = 64
CONV_CH = D_MIX // 4
CONV_K = 3
ATT_HEADS = D_MIX // 2 // HEAD_DIM
ATT_KV_HEADS = 2
ATT_GROUP = ATT_HEADS // ATT_KV_HEADS
WINDOW = 128
BLOCK = 128
GLA_HEADS = D_MIX // 4 // HEAD_DIM
GLA_DK = HEAD_DIM
GLA_DV = HEAD_DIM
GLA_RANK = 16
GLA_NORMALIZER = 16.0
GLA_CHUNK = 32
D_FF = ((8 * D_MODEL + 3 * 256 - 1) // (3 * 256)) * 256
N_MOD = 6
ROPE_BASE = 10000.0
EPS = 1e-6
COL_SIZES = (CONV_CH, CONV_CH, CONV_CH,
             ATT_HEADS * HEAD_DIM, ATT_KV_HEADS * HEAD_DIM, ATT_KV_HEADS * HEAD_DIM,
             GLA_HEADS * GLA_DK, GLA_HEADS * GLA_DK, GLA_HEADS * GLA_DV, GLA_HEADS * GLA_DV,
             2 * GLA_RANK)
N_IN = sum(COL_SIZES)
COL_SPLITS = tuple(int(v) for v in np.cumsum(COL_SIZES)[:-1])

kernel_name = "hybrid_parallel_groups_dit"


def rmsnorm(x, g):
    x32 = x.astype(jnp.float32)
    y = x32 * lax.rsqrt(jnp.mean(x32 * x32, axis=-1, keepdims=True) + EPS)
    return (y * g.astype(jnp.float32)).astype(x.dtype)


def heads(a, n):
    return a.reshape(a.shape[:-1] + (n, a.shape[-1] // n))


def axial_rope_tables(rows):
    t = jnp.arange(rows * GRID_W)
    row = (t // GRID_W).astype(jnp.float32)
    col = (t % GRID_W).astype(jnp.float32)
    n_freq = HEAD_DIM // 4
    inv_freq = ROPE_BASE ** (-jnp.arange(n_freq, dtype=jnp.float32) / n_freq)
    ang = jnp.stack([row[:, None] * inv_freq, col[:, None] * inv_freq], axis=1)
    return jnp.cos(ang), jnp.sin(ang)


def apply_rope(x, cos, sin):
    B, S, H, D = x.shape
    xs = x.astype(jnp.float32).reshape(B, S, H, 2, D // 2)
    half = D // 4
    x1, x2 = xs[..., :half], xs[..., half:]
    c = cos[None, :, None]
    s = sin[None, :, None]
    out = jnp.concatenate([x1 * c - x2 * s, x2 * c + x1 * s], axis=-1)
    return out.reshape(B, S, H, D).astype(x.dtype)


def short_conv(x_in, b_gate, c_gate, w):
    T = x_in.shape[1]
    u = c_gate * x_in
    up = jnp.pad(u, ((0, 0), (CONV_K // 2, CONV_K // 2), (0, 0)))
    y = sum(w[j] * up[:, j:j + T] for j in range(CONV_K))
    return b_gate * y


def softmax_with_sink(scores, sink):
    s = jnp.broadcast_to(sink.astype(jnp.float32).reshape(ATT_KV_HEADS, ATT_GROUP, 1, 1),
                         scores.shape[:-1] + (1,))
    p = jax.nn.softmax(jnp.concatenate([s, scores], axis=-1), axis=-1)
    return p[..., 1:]


def context_attention(q, k, v, sink):
    B, L = q.shape[:2]
    qg = q.reshape(B, L, ATT_KV_HEADS, ATT_GROUP, HEAD_DIM)
    s = jnp.einsum('bqhgd,bkhd->bhgqk', qg, k).astype(jnp.float32) * HEAD_DIM ** -0.5
    p = softmax_with_sink(s, sink).astype(v.dtype)
    o = jnp.einsum('bhgqk,bkhd->bqhgd', p, v)
    return o.reshape(B, L, ATT_HEADS * HEAD_DIM)


def window_attention(q, k, v, k_ctx, v_ctx, sink):
    B, S = q.shape[:2]
    L = k_ctx.shape[1]
    nb = S // BLOCK
    qb = q.reshape(B, nb, BLOCK, ATT_KV_HEADS, ATT_GROUP, HEAD_DIM).transpose(1, 0, 2, 3, 4, 5)
    pad = ((0, 0), (BLOCK, BLOCK), (0, 0), (0, 0))
    kp = jnp.pad(k, pad)
    vp = jnp.pad(v, pad)
    r = jnp.arange(BLOCK)
    j = jnp.arange(3 * BLOCK)
    scale = HEAD_DIM ** -0.5

    def one_block(args):
        qi, i = args
        start = i * BLOCK
        ks = lax.dynamic_slice_in_dim(kp, start, 3 * BLOCK, axis=1)
        vs = lax.dynamic_slice_in_dim(vp, start, 3 * BLOCK, axis=1)
        s_ctx = jnp.einsum('bqhgd,bkhd->bhgqk', qi, k_ctx).astype(jnp.float32)
        s_loc = jnp.einsum('bqhgd,bkhd->bhgqk', qi, ks).astype(jnp.float32)
        tq = start + r
        tk = start - BLOCK + j
        valid = (jnp.abs(tq[:, None] - tk[None, :]) <= WINDOW) & (tk[None, :] >= 0) & (tk[None, :] < S)
        s_loc = jnp.where(valid, s_loc, -jnp.inf)
        p = softmax_with_sink(jnp.concatenate([s_ctx, s_loc], axis=-1) * scale, sink).astype(v.dtype)
        o = (jnp.einsum('bhgqk,bkhd->bqhgd', p[..., :L], v_ctx)
             + jnp.einsum('bhgqk,bkhd->bqhgd', p[..., L:], vs))
        return o.reshape(B, BLOCK, ATT_HEADS * HEAD_DIM)

    out = lax.map(one_block, (qb, jnp.arange(nb)))
    return out.transpose(1, 0, 2, 3).reshape(B, S, ATT_HEADS * HEAD_DIM)


def gla_chunk_scan(q, k, v, log_g, state0, with_output):
    B, T, H, _ = q.shape
    n = T // GLA_CHUNK

    def to_chunks(a):
        return a.reshape(B, n, GLA_CHUNK, H, a.shape[-1]).transpose(1, 0, 3, 2, 4)

    lower_tri = jnp.tril(jnp.ones((GLA_CHUNK, GLA_CHUNK), dtype=bool))[:, :, None]

    def step(state, inp):
        qc, kc, vc, gc = inp
        b = jnp.cumsum(gc.astype(jnp.float32), axis=2)
        b_last = b[:, :, -1:, :]
        new_state = (jnp.exp(b_last[:, :, 0, :])[..., None] * state
                     + jnp.einsum('bhsk,bhsv->bhkv', kc * jnp.exp(b_last - b), vc))
        if not with_output:
            return new_state, None
        diff = jnp.where(lower_tri, b[:, :, :, None, :] - b[:, :, None, :, :], -jnp.inf)
        a = jnp.einsum('bhtk,bhsk,bhtsk->bhts', qc, kc, jnp.exp(diff))
        o = (jnp.einsum('bhts,bhsv->bhtv', a, vc)
             + jnp.einsum('bhtk,bhkv->bhtv', qc * jnp.exp(b), state))
        return new_state, o

    state, o = lax.scan(step, state0, (to_chunks(q), to_chunks(k), to_chunks(v), to_chunks(log_g)))
    if not with_output:
        return None, state
    return o.transpose(1, 0, 3, 2, 4).reshape(B, T, H, v.shape[-1]), state


def gla_output(o, g, norm_g):
    o32 = o.astype(jnp.float32)
    o32 = o32 * lax.rsqrt(jnp.mean(o32 * o32, axis=-1, keepdims=True) + EPS) * norm_g.astype(jnp.float32)
    B, T = o.shape[:2]
    return (o32.reshape(B, T, GLA_HEADS * GLA_DV) * jax.nn.silu(g.astype(jnp.float32))).astype(g.dtype)


def gla_bidir(q, k, v, lr, g, q_c, k_c, v_c, lr_c, g_c, w_gate, b_gate, norm_g, ctx_out):
    B = q.shape[0]
    q = heads(q, GLA_HEADS) * GLA_DK ** -0.5
    k = heads(k, GLA_HEADS)
    v = heads(v, GLA_HEADS)
    q_c = heads(q_c, GLA_HEADS) * GLA_DK ** -0.5
    k_c = heads(k_c, GLA_HEADS)
    v_c = heads(v_c, GLA_HEADS)
    outs_x, outs_c = [], []
    for d in range(2):
        sl = slice(d * GLA_RANK, (d + 1) * GLA_RANK)
        gate_x = heads(jax.nn.log_sigmoid(lr[..., sl] @ w_gate[d] + b_gate[d]) / GLA_NORMALIZER, GLA_HEADS)
        gate_c = heads(jax.nn.log_sigmoid(lr_c[..., sl] @ w_gate[d] + b_gate[d]) / GLA_NORMALIZER, GLA_HEADS)
        flip = (lambda a: jnp.flip(a, axis=1)) if d == 1 else (lambda a: a)
        state0 = jnp.zeros((B, GLA_HEADS, GLA_DK, GLA_DV), jnp.float32)
        o_c, s_c = gla_chunk_scan(flip(q_c), flip(k_c), flip(v_c), flip(gate_c), state0, ctx_out)
        o_x, _ = gla_chunk_scan(flip(q), flip(k), flip(v), flip(gate_x), s_c, True)
        outs_x.append(flip(o_x))
        if ctx_out:
            outs_c.append(flip(o_c))
    y_x = gla_output(outs_x[0] + outs_x[1], g, norm_g)
    y_c = gla_output(outs_c[0] + outs_c[1], g_c, norm_g) if ctx_out else None
    return y_x, y_c


def swiglu(h, w_up, w_down):
    a, b = jnp.split(h @ w_up, 2, axis=-1)
    return (jax.nn.silu(a) * b) @ w_down


def layer(x, ctx, mod_x, mod_c, cos, sin, g1, g2, w_in, conv_w, sink, gate_w, gate_b, norm_g,
          w_out, w_up, w_down, ctx_out):
    sh1, sc1, gt1, sh2, sc2, gt2 = jnp.split(mod_x[:, None, :], N_MOD, axis=-1)
    csh1, csc1, cgt1, csh2, csc2, cgt2 = jnp.split(mod_c, N_MOD, axis=-1)
    hx = rmsnorm(x, g1) * (1 + sc1) + sh1
    hc = rmsnorm(ctx, g1) * (1 + csc1) + csh1
    (xc_in, xc_b, xc_c, xq, xk, xv, xgq, xgk, xgv, xgg, xlr) = jnp.split(hx @ w_in, COL_SPLITS, axis=-1)
    (cc_in, cc_b, cc_c, cq, ck, cv, cgq, cgk, cgv, cgg, clr) = jnp.split(hc @ w_in, COL_SPLITS, axis=-1)
    k_ctx = heads(ck, ATT_KV_HEADS)
    v_ctx = heads(cv, ATT_KV_HEADS)
    conv_x = short_conv(xc_in, xc_b, xc_c, conv_w)
    attn_x = window_attention(apply_rope(heads(xq, ATT_HEADS), cos, sin),
                              apply_rope(heads(xk, ATT_KV_HEADS), cos, sin),
                              heads(xv, ATT_KV_HEADS), k_ctx, v_ctx, sink)
    gla_x, gla_c = gla_bidir(xgq, xgk, xgv, xlr, xgg, cgq, cgk, cgv, clr, cgg,
                             gate_w, gate_b, norm_g, ctx_out)
    x = x + gt1 * (jnp.concatenate([conv_x, attn_x, gla_x], axis=-1) @ w_out)
    x = x + gt2 * swiglu(rmsnorm(x, g2) * (1 + sc2) + sh2, w_up, w_down)
    if ctx_out:
        conv_c = short_conv(cc_in, cc_b, cc_c, conv_w)
        attn_c = context_attention(heads(cq, ATT_HEADS), k_ctx, v_ctx, sink)
        ctx = ctx + cgt1 * (jnp.concatenate([conv_c, attn_c, gla_c], axis=-1) @ w_out)
        ctx = ctx + cgt2 * swiglu(rmsnorm(ctx, g2) * (1 + csc2) + csh2, w_up, w_down)
    return x, ctx


def setup_inputs(seed: int = 0) -> dict:
    key = jax.random.key(seed)
    ks = jax.random.split(key, 18)

    def nrm(k, shape, s):
        return jax.random.normal(k, shape, jnp.float32) * s

    return {
        "x": nrm(ks[0], (BATCH, SEQ, D_MODEL), 1.0),
        "c": nrm(ks[1], (BATCH, D_MODEL), 1.0),
        "ctx": nrm(ks[2], (BATCH, CTX_LEN, D_MODEL), 1.0),
        "c_ctx": nrm(ks[3], (D_MODEL,), 1.0),
        "w_mod": nrm(ks[4], (DEPTH, D_MODEL, N_MOD * D_MODEL), 0.02),
        "b_mod": nrm(ks[5], (DEPTH, N_MOD * D_MODEL), 0.01),
        "norm1_g": 1.0 + nrm(ks[6], (DEPTH, D_MODEL), 0.02),
        "norm2_g": 1.0 + nrm(ks[7], (DEPTH, D_MODEL), 0.02),
        "w_in": nrm(ks[8], (DEPTH, D_MODEL, N_IN), D_MODEL ** -0.5),
        "conv_w": nrm(ks[9], (DEPTH, CONV_K, CONV_CH), CONV_K ** -0.5),
        "attn_sink": nrm(ks[10], (DEPTH, ATT_HEADS), 1.0),
        "gla_gate_w": nrm(ks[11], (DEPTH, 2, GLA_RANK, GLA_HEADS * GLA_DK), GLA_RANK ** -0.5),
        "gla_gate_b": nrm(ks[12], (DEPTH, 2, GLA_HEADS * GLA_DK), 0.1),
        "gla_norm_g": 1.0 + nrm(ks[13], (DEPTH, GLA_DV), 0.02),
        "w_out": nrm(ks[14], (DEPTH, D_MIX, D_MODEL), D_MIX ** -0.5),
        "w_up": nrm(ks[15], (DEPTH, D_MODEL, 2 * D_FF), D_MODEL ** -0.5),
        "w_down": nrm(ks[16], (DEPTH, D_FF, D_MODEL), D_FF ** -0.5),
        "final_norm_g": 1.0 + nrm(ks[17], (D_MODEL,), 0.02),
    }


def reference(x, c, ctx, c_ctx, w_mod, b_mod, norm1_g, norm2_g, w_in, conv_w, attn_sink,
              gla_gate_w, gla_gate_b, gla_norm_g, w_out, w_up, w_down, final_norm_g):
    ROWS = x.shape[1] // GRID_W
    cos, sin = axial_rope_tables(ROWS)
    for l in range(DEPTH):
        mod_x = jax.nn.silu(c) @ w_mod[l] + b_mod[l]
        mod_c = jax.nn.silu(c_ctx) @ w_mod[l] + b_mod[l]
        x, ctx = layer(x, ctx, mod_x, mod_c, cos, sin, norm1_g[l], norm2_g[l], w_in[l], conv_w[l],
                       attn_sink[l], gla_gate_w[l], gla_gate_b[l], gla_norm_g[l], w_out[l],
                       w_up[l], w_down[l], l < DEPTH - 1)
    return rmsnorm(x, final_norm_g)
```

```cpp
#include <hip/hip_runtime.h>
#include <hip/hip_cooperative_groups.h>
#include <cstdio>
#include <cstdint>
namespace cg = cooperative_groups;

#define DI __device__ __forceinline__
#define LAS __attribute__((address_space(3)))
typedef unsigned short u16;
typedef short bf16x8 __attribute__((ext_vector_type(8)));
typedef float f32x16 __attribute__((ext_vector_type(16)));
typedef float f32x4 __attribute__((ext_vector_type(4)));
typedef unsigned u32x4 __attribute__((ext_vector_type(4)));
typedef unsigned u32x2 __attribute__((ext_vector_type(2)));

constexpr int D = 1024, NB = 2, SEQ = 16384, CTX = 256, DEPTH = 4;
constexpr int NIN = 2592, NINP = 2688, DFF = 2816;
constexpr int MLAT = NB * SEQ, MCTX = NB * CTX, MROWS = MLAT + MCTX;
constexpr int C_CX = 0, C_CB = 256, C_CC = 512, C_Q = 768, C_K = 1280, C_V = 1408, C_GQ = 1536, C_GK = 1792, C_GV = 2048, C_GG = 2304, C_LR = 2560;
constexpr int NCH = 260;
constexpr float EPS = 1e-6f;
constexpr int XCD_BAR_WORDS_C = 3456;
constexpr float LOG2E = 1.4426950408889634f;

constexpr size_t WL_IN = 0, WL_OUT = (size_t)NINP * D, WL_UP = WL_OUT + (size_t)D * D, WL_DOWN = WL_UP + (size_t)2 * DFF * D, WL_SIZE = WL_DOWN + (size_t)D * DFF;
constexpr size_t OFF_WB = 0;
constexpr size_t OFF_XN = OFF_WB + WL_SIZE * DEPTH * 2;
constexpr size_t OFF_PROJ = OFF_XN + (size_t)MROWS * D * 2;
constexpr size_t OFF_CAT = OFF_PROJ + (size_t)MROWS * NIN * 2;
constexpr size_t OFF_XC = OFF_CAT + (size_t)MROWS * D * 2;
constexpr size_t OFF_MOD = OFF_XC + (size_t)MCTX * D * 4;
constexpr size_t OFF_ROPE = OFF_MOD + (size_t)DEPTH * 3 * 6 * D * 4;
constexpr size_t OFF_GST = OFF_ROPE + 2 * 256 * 16 * 4;
constexpr size_t OFF_GD = OFF_GST + (size_t)16 * NCH * 4096 * 4;
constexpr size_t OFF_PART = OFF_GD + (size_t)16 * NCH * 64 * 4;
constexpr size_t OFF_BAR = OFF_PART + (size_t)4 * MCTX * D * 4;
constexpr size_t WS_END = OFF_BAR + XCD_BAR_WORDS_C * 4;
static_assert(WS_END <= 536870912ull, "workspace too large");
static_assert((size_t)MROWS * DFF * 2 <= OFF_XC - OFF_PROJ, "h overlay does not fit");

struct Params {
    const float *x, *c, *ctx, *c_ctx, *w_mod, *b_mod, *g1, *g2, *w_in, *conv_w, *sink, *gate_w, *gate_b, *gnorm, *w_out, *w_up, *w_down, *gfinal;
    float* out; unsigned char* ws;
};

constexpr int LROW = 72;
constexpr int TILE_B = 128 * LROW * 2;
constexpr int T64_B = 64 * LROW * 2;
constexpr int LDS_BYTES = 4 * TILE_B;

typedef __bf16 bf16x2_t __attribute__((ext_vector_type(2)));
typedef float f32x2_t __attribute__((ext_vector_type(2)));
DI unsigned pk2(float lo, float hi) { f32x2_t v = {lo, hi}; bf16x2_t r = __builtin_convertvector(v, bf16x2_t); return __builtin_bit_cast(unsigned, r); }
DI u16 f2bf(float x) { return (u16)(pk2(x, 0.f) & 0xffffu); }
DI float bflo(unsigned w) { return __uint_as_float(w << 16); }
DI float bfhi(unsigned w) { return __uint_as_float(w & 0xffff0000u); }
DI float bf2f(u16 v) { return __uint_as_float(((unsigned)v) << 16); }
DI void unpack8(u32x4 v, float (&f)[8]) { f[0] = bflo(v.x); f[1] = bfhi(v.x); f[2] = bflo(v.y); f[3] = bfhi(v.y); f[4] = bflo(v.z); f[5] = bfhi(v.z); f[6] = bflo(v.w); f[7] = bfhi(v.w); }
DI u32x4 pack8(const float (&f)[8]) { u32x4 v; v.x = pk2(f[0], f[1]); v.y = pk2(f[2], f[3]); v.z = pk2(f[4], f[5]); v.w = pk2(f[6], f[7]); return v; }
DI int otid() { int t = threadIdx.x; asm volatile("" : "+v"(t)); return t; }
DI int pi32(int r) { return (r & 0x13) | ((r & 4) << 1) | ((r & 8) >> 1); }
DI int crow(int i, int h) { return (i & 3) + 8 * (i >> 2) + 4 * h; }
DI float wave_sum(float v) {
#pragma unroll
    for (int o = 1; o < 64; o <<= 1) v += __shfl_xor(v, o);
    return v;
}
DI float siluf(float a) { return a * __builtin_amdgcn_rcpf(1.f + __expf(-a)); }
#define MFMA32(a, b, c) __builtin_amdgcn_mfma_f32_32x32x16_bf16((a), (b), (c), 0, 0, 0)
DI f32x16 zero16() { f32x16 z;
#pragma unroll
    for (int i = 0; i < 16; ++i) z[i] = 0.f; return z; }

DI int up_dest(int n) { return n < DFF ? ((n >> 5) * 64 + (n & 31)) : ((((n - DFF) >> 5) * 64) + 32 + ((n - DFF) & 31)); }

template <int MODE>
DI void transpose_item(unsigned char* lds, const float* __restrict__ W, int K, int N, u16* __restrict__ WT, int kb, int nb) {
    float* tile = (float*)lds;
    const int tid = otid(), k0 = kb * 64, n0 = nb * 64;
    __syncthreads();
    {
        const int n = tid & 63, kq = tid >> 6;
#pragma unroll 4
        for (int i = 0; i < 16; ++i) { const int k = kq + 4 * i; tile[k * 65 + n] = (n0 + n < N) ? W[(size_t)(k0 + k) * N + n0 + n] : 0.f; }
    }
    __syncthreads();
    {
        const int ch = tid & 7;
#pragma unroll
        for (int j = 0; j < 2; ++j) {
            const int nn = (tid >> 3) + 32 * j;
            float f[8];
#pragma unroll
            for (int q = 0; q < 8; ++q) f[q] = tile[(8 * ch + q) * 65 + nn];
            const int dest = MODE == 1 ? up_dest(n0 + nn) : (n0 + nn);
            *(u32x4*)(WT + (size_t)dest * K + k0 + 8 * ch) = pack8(f);
        }
    }
}

DI void weights_phase(unsigned char* lds, const Params& p, int lw, int first_blk) {
    u16* wb = (u16*)(p.ws + OFF_WB);
    constexpr int I_IN = 16 * (NINP / 64), I_OUT = 16 * 16, I_UP = 16 * (2 * DFF / 64), I_DOWN = (DFF / 64) * 16, I_L = I_IN + I_OUT + I_UP + I_DOWN;
    const int G = gridDim.x;
    int me = (int)blockIdx.x - first_blk; if (me < 0) me += G;
    for (int it = me; it < I_L; it += G) {
        const int l = lw; int r = it;
        u16* wl = wb + (size_t)l * WL_SIZE;
        if (r < I_IN) { transpose_item<0>(lds, p.w_in + (size_t)l * D * NIN, D, NIN, wl + WL_IN, r / (NINP / 64), r % (NINP / 64)); continue; } r -= I_IN;
        if (r < I_OUT) { transpose_item<0>(lds, p.w_out + (size_t)l * D * D, D, D, wl + WL_OUT, r / 16, r % 16); continue; } r -= I_OUT;
        if (r < I_UP) { transpose_item<1>(lds, p.w_up + (size_t)l * D * 2 * DFF, D, 2 * DFF, wl + WL_UP, r / (2 * DFF / 64), r % (2 * DFF / 64)); continue; } r -= I_UP;
        transpose_item<0>(lds, p.w_down + (size_t)l * DFF * D, DFF, D, wl + WL_DOWN, r / 16, r % 16);
    }
    __syncthreads();
}

DI void prologue_phase(unsigned char* lds, const Params& p) {
    const int tid = otid();
    weights_phase(lds, p, 0, 0);
    __syncthreads();
    float* sv = (float*)lds;
    float* red = sv + 3 * D;
    for (int i = tid; i < 3 * D; i += 256) { const int v = i >> 10, k = i & 1023; const float c = v < 2 ? p.c[v * D + k] : p.c_ctx[k]; sv[i] = siluf(c); }
    __syncthreads();
    float* mod = (float*)(p.ws + OFF_MOD);
    for (int it = blockIdx.x; it < DEPTH * 96; it += gridDim.x) {
        const int l = it / 96, n0 = (it % 96) * 64, n = tid & 63, kq = tid >> 6;
        const float* w = p.w_mod + (size_t)l * D * 6 * D + (size_t)(kq * 256) * 6 * D + n0 + n;
        float a0 = 0.f, a1 = 0.f, a2 = 0.f;
#pragma unroll 8
        for (int k = 0; k < 256; ++k) { const float wv = w[(size_t)k * 6 * D]; const int kk = kq * 256 + k; a0 += sv[kk] * wv; a1 += sv[D + kk] * wv; a2 += sv[2 * D + kk] * wv; }
        red[(kq * 3 + 0) * 64 + n] = a0; red[(kq * 3 + 1) * 64 + n] = a1; red[(kq * 3 + 2) * 64 + n] = a2;
        __syncthreads();
        if (tid < 192) { const int v = tid >> 6, nn = tid & 63; float s = p.b_mod[l * 6 * D + n0 + nn];
#pragma unroll
            for (int q = 0; q < 4; ++q) s += red[(q * 3 + v) * 64 + nn];
            mod[((size_t)l * 3 + v) * 6 * D + n0 + nn] = s; }
        __syncthreads();
    }
    {
        const f32x4* s4 = (const f32x4*)p.ctx; f32x4* d4 = (f32x4*)(p.ws + OFF_XC);
        for (int i = blockIdx.x * 256 + tid; i < MCTX * D / 4; i += gridDim.x * 256) d4[i] = s4[i];
    }
    {
        const int g = blockIdx.x * 256 + tid;
        if (g < 4096) {
            const int pos = g >> 4, i = g & 15;
            const float inv = exp2f(-(float)i * (13.287712379549449f / 16.f));
            const float ang = (float)pos * inv;
            const double a = (double)ang, k = rint(a * 0.15915494309189535), rr = a - k * 6.283185307179586;
            const float rf = (float)rr;
            float* rc = (float*)(p.ws + OFF_ROPE);
            rc[g] = __cosf(rf); rc[4096 + g] = __sinf(rf);
        }
    }
}

DI void norm_phase(const Params& p, int l, int which) {
    const int tid = otid(), lane = tid & 63, wave = tid >> 6;
    const float* lat = (l == 0 && which == 0) ? p.x : p.out;
    const float* cx = (const float*)(p.ws + OFF_XC);
    const float* g = (which == 0 ? p.g1 : p.g2) + l * D;
    const float* mod = (const float*)(p.ws + OFF_MOD) + (size_t)l * 3 * 6 * D;
    u16* xn = (u16*)(p.ws + OFF_XN);
    const int nrows = (l == DEPTH - 1 && which == 1) ? MLAT : MROWS;
    const bool fold = which == 1 || l > 0;
    const float* part = (const float*)(p.ws + OFF_PART);
    const float* fgate = (const float*)(p.ws + OFF_MOD) + (size_t)(which == 1 ? l : l - 1) * 3 * 6 * D + 2 * 6 * D + (which == 1 ? 2 * D : 5 * D);
    const int NW = gridDim.x * 4, gw = blockIdx.x * 4 + wave;
    {
        const int rpw = ((MLAT + NW - 1) / NW + 3) & ~3;
        const int rbeg = gw * rpw, rend = (rbeg + rpw) < MLAT ? (rbeg + rpw) : MLAT;
        int cur_var = -1;
        f32x4 ga[4], sb[4];
        for (int r0 = rbeg; r0 < rend; r0 += 4) {
            const int var = r0 < SEQ ? 0 : 1;
            if (var != cur_var) {
                cur_var = var;
                const float* sh = mod + var * 6 * D + (which == 0 ? 0 : 3 * D);
                const float* sc = sh + D;
#pragma unroll
                for (int j = 0; j < 4; ++j) {
                    const int col = j * 256 + lane * 4;
                    const f32x4 gg = *(const f32x4*)(g + col), s1 = *(const f32x4*)(sc + col);
                    ga[j].x = gg.x * (1.f + s1.x); ga[j].y = gg.y * (1.f + s1.y); ga[j].z = gg.z * (1.f + s1.z); ga[j].w = gg.w * (1.f + s1.w);
                    sb[j] = *(const f32x4*)(sh + col);
                }
            }
            f32x4 v[4][4]; float ss[4];
#pragma unroll
            for (int q = 0; q < 4; ++q) {
                const int row = (r0 + q) < rend ? (r0 + q) : (rend - 1);
#pragma unroll
                for (int j = 0; j < 4; ++j) v[q][j] = *(const f32x4*)(lat + (size_t)row * D + j * 256 + lane * 4);
            }
#pragma unroll
            for (int q = 0; q < 4; ++q) {
                ss[q] = 0.f;
#pragma unroll
                for (int j = 0; j < 4; ++j) ss[q] += v[q][j].x * v[q][j].x + v[q][j].y * v[q][j].y + v[q][j].z * v[q][j].z + v[q][j].w * v[q][j].w;
                ss[q] = wave_sum(ss[q]);
            }
#pragma unroll
            for (int q = 0; q < 4; ++q) {
                if (r0 + q >= rend) continue;
                const float rs = rsqrtf(ss[q] * (1.f / D) + EPS);
#pragma unroll
                for (int j = 0; j < 4; ++j) {
                    f32x4 o;
                    o.x = v[q][j].x * rs * ga[j].x + sb[j].x; o.y = v[q][j].y * rs * ga[j].y + sb[j].y;
                    o.z = v[q][j].z * rs * ga[j].z + sb[j].z; o.w = v[q][j].w * rs * ga[j].w + sb[j].w;
                    u32x2 w; w.x = pk2(o.x, o.y); w.y = pk2(o.z, o.w);
                    *(u32x2*)(xn + (size_t)(r0 + q) * D + j * 256 + lane * 4) = w;
                }
            }
        }
    }
    for (int row = MLAT + gw; row < nrows; row += NW) {
        const float* xr = cx + (size_t)(row - MLAT) * D;
        f32x4 v[4]; float ss = 0.f;
#pragma unroll
        for (int j = 0; j < 4; ++j) v[j] = *(const f32x4*)(xr + j * 256 + lane * 4);
        if (fold) {
            const float* pp = part + (size_t)(row - MLAT) * D;
            float* xw = (float*)(p.ws + OFF_XC) + (size_t)(row - MLAT) * D;
#pragma unroll
            for (int j = 0; j < 4; ++j) {
                const int col = j * 256 + lane * 4;
                const f32x4 gt = *(const f32x4*)(fgate + col);
                const f32x4 p0 = *(const f32x4*)(pp + col), p1 = *(const f32x4*)(pp + (size_t)MCTX * D + col), p2 = *(const f32x4*)(pp + (size_t)2 * MCTX * D + col), p3 = *(const f32x4*)(pp + (size_t)3 * MCTX * D + col);
                v[j].x += gt.x * ((p0.x + p1.x) + (p2.x + p3.x)); v[j].y += gt.y * ((p0.y + p1.y) + (p2.y + p3.y));
                v[j].z += gt.z * ((p0.z + p1.z) + (p2.z + p3.z)); v[j].w += gt.w * ((p0.w + p1.w) + (p2.w + p3.w));
                *(f32x4*)(xw + col) = v[j];
            }
        }
#pragma unroll
        for (int j = 0; j < 4; ++j) ss += v[j].x * v[j].x + v[j].y * v[j].y + v[j].z * v[j].z + v[j].w * v[j].w;
        const float rs = rsqrtf(wave_sum(ss) * (1.f / D) + EPS);
        const float* sh = mod + 2 * 6 * D + (which == 0 ? 0 : 3 * D);
        const float* sc = sh + D;
#pragma unroll
        for (int j = 0; j < 4; ++j) {
            const int col = j * 256 + lane * 4;
            const f32x4 gg = *(const f32x4*)(g + col), s1 = *(const f32x4*)(sc + col), s0 = *(const f32x4*)(sh + col);
            f32x4 o;
            o.x = v[j].x * rs * gg.x * (1.f + s1.x) + s0.x; o.y = v[j].y * rs * gg.y * (1.f + s1.y) + s0.y;
            o.z = v[j].z * rs * gg.z * (1.f + s1.z) + s0.z; o.w = v[j].w * rs * gg.w * (1.f + s1.w) + s0.w;
            u32x2 w; w.x = pk2(o.x, o.y); w.y = pk2(o.z, o.w);
            *(u32x2*)(xn + (size_t)row * D + col) = w;
        }
    }
}

DI void final_norm_phase(const Params& p) {
    const int tid = otid(), lane = tid & 63, wave = tid >> 6;
    const int W = gridDim.x * 4;
    const f32x4 gg0 = *(const f32x4*)(p.gfinal + lane * 4), gg1 = *(const f32x4*)(p.gfinal + 256 + lane * 4), gg2 = *(const f32x4*)(p.gfinal + 512 + lane * 4), gg3 = *(const f32x4*)(p.gfinal + 768 + lane * 4);
    const f32x4 gg[4] = {gg0, gg1, gg2, gg3};
    for (int row0 = blockIdx.x * 4 + wave; row0 < MLAT; row0 += 4 * W) {
        f32x4 v[4][4]; float ss[4];
#pragma unroll
        for (int q = 0; q < 4; ++q) {
            const int row = row0 + q * W;
            ss[q] = 0.f;
#pragma unroll
            for (int j = 0; j < 4; ++j) v[q][j] = row < MLAT ? *(const f32x4*)(p.out + (size_t)row * D + j * 256 + lane * 4) : (f32x4){0.f, 0.f, 0.f, 0.f};
        }
#pragma unroll
        for (int q = 0; q < 4; ++q) {
#pragma unroll
            for (int j = 0; j < 4; ++j) ss[q] += v[q][j].x * v[q][j].x + v[q][j].y * v[q][j].y + v[q][j].z * v[q][j].z + v[q][j].w * v[q][j].w;
            ss[q] = wave_sum(ss[q]);
        }
#pragma unroll
        for (int q = 0; q < 4; ++q) {
            const int row = row0 + q * W;
            if (row >= MLAT) continue;
            const float rs = rsqrtf(ss[q] * (1.f / D) + EPS);
#pragma unroll
            for (int j = 0; j < 4; ++j) {
                f32x4 o; o.x = v[q][j].x * rs * gg[j].x; o.y = v[q][j].y * rs * gg[j].y; o.z = v[q][j].z * rs * gg[j].z; o.w = v[q][j].w * rs * gg[j].w;
                *(f32x4*)(p.out + (size_t)row * D + j * 256 + lane * 4) = o;
            }
        }
    }
}

template <class Epi>
DI void gemm_tile(unsigned char* lds, const u16* __restrict__ A, int lda, const u16* __restrict__ Bt, int ldb, int K, int m0, int n0, const Epi& epi) {
    const int tid = otid(), lane = tid & 63, wave = tid >> 6, wm = wave >> 1, wn = wave & 1, r = lane & 31, h = lane >> 5;
    const u16* ga = A + (size_t)(m0 + (tid >> 3)) * lda + (tid & 7) * 8;
    const u16* gb = Bt + (size_t)(n0 + (tid >> 3)) * ldb + (tid & 7) * 8;
    const int soff = ((tid >> 3) * LROW + (tid & 7) * 8) * 2;
    const int aoff = ((64 * wm + r) * LROW + 8 * h) * 2, boff = TILE_B + ((64 * wn + pi32(r)) * LROW + 8 * h) * 2;
    u32x4 ra[4], rb[4];
    f32x16 acc[2][2];
#pragma unroll
    for (int a = 0; a < 2; ++a)
#pragma unroll
        for (int b = 0; b < 2; ++b) acc[a][b] = zero16();
    const int nk = K >> 6;
#pragma unroll
    for (int i = 0; i < 4; ++i) { ra[i] = *(const u32x4*)(ga + (size_t)(32 * i) * lda); rb[i] = *(const u32x4*)(gb + (size_t)(32 * i) * ldb); }
#pragma unroll
    for (int i = 0; i < 4; ++i) { *(u32x4*)(lds + soff + i * 32 * LROW * 2) = ra[i]; *(u32x4*)(lds + TILE_B + soff + i * 32 * LROW * 2) = rb[i]; }
    __syncthreads();
    for (int kt = 0; kt < nk; ++kt) {
        const bool more = kt + 1 < nk;
        if (more) {
            const int k0 = (kt + 1) * 64;
#pragma unroll
            for (int i = 0; i < 4; ++i) { ra[i] = *(const u32x4*)(ga + (size_t)(32 * i) * lda + k0); rb[i] = *(const u32x4*)(gb + (size_t)(32 * i) * ldb + k0); }
        }
        __builtin_amdgcn_sched_barrier(0);
        const unsigned char* st = lds + (kt & 1) * 2 * TILE_B;
#pragma unroll
        for (int s = 0; s < 4; ++s) {
            bf16x8 af[2], bfr[2];
#pragma unroll
            for (int mi = 0; mi < 2; ++mi) af[mi] = *(const bf16x8*)(st + aoff + mi * 32 * LROW * 2 + s * 32);
#pragma unroll
            for (int ni = 0; ni < 2; ++ni) bfr[ni] = *(const bf16x8*)(st + boff + ni * 32 * LROW * 2 + s * 32);
#pragma unroll
            for (int mi = 0; mi < 2; ++mi)
#pragma unroll
                for (int ni = 0; ni < 2; ++ni) acc[mi][ni] = MFMA32(bfr[ni], af[mi], acc[mi][ni]);
        }
        if (more) {
            unsigned char* sn = lds + ((kt + 1) & 1) * 2 * TILE_B;
#pragma unroll
            for (int i = 0; i < 4; ++i) { *(u32x4*)(sn + soff + i * 32 * LROW * 2) = ra[i]; *(u32x4*)(sn + TILE_B + soff + i * 32 * LROW * 2) = rb[i]; }
        }
        __syncthreads();
    }
    epi.template operator()<2>(acc, m0 + 64 * wm, n0 + 64 * wn, r, h);
}

template <class Epi>
DI void gemm_phase(unsigned char* lds, const u16* A, int lda, const u16* Bt, int ldb, int K, int mtiles, int ntiles, const Epi& epi) {
    const int G = gridDim.x;
    if ((G & 7) == 0) {
        const int xcd = blockIdx.x & 7, local = blockIdx.x >> 3, nlocal = G >> 3;
        const int nmx = (mtiles - xcd + 7) >> 3, total = nmx * ntiles;
        for (int lt = local; lt < total; lt += nlocal) { const int mj = lt / ntiles, n = lt % ntiles; gemm_tile(lds, A, lda, Bt, ldb, K, (xcd + 8 * mj) * 128, n * 128, epi); }
    } else {
        for (int t = blockIdx.x; t < mtiles * ntiles; t += G) gemm_tile(lds, A, lda, Bt, ldb, K, (t / ntiles) * 128, (t % ntiles) * 128, epi);
    }
}

constexpr int A4_B = 256 * LROW * 2, B4_B = 128 * LROW * 2, ST4_B = A4_B + B4_B;
static_assert(ST4_B <= LDS_BYTES, "tile4 lds");
template <class Epi>
DI void gemm_tile4(unsigned char* lds, const u16* __restrict__ A, int lda, const u16* __restrict__ Bt, int ldb, int K, int m0, int n0, const Epi& epi) {
    const int tid = otid(), lane = tid & 63, wave = tid >> 6, wm = wave >> 1, wn = wave & 1, r = lane & 31, h = lane >> 5;
    const u16* ga = A + (size_t)(m0 + (tid >> 3)) * lda + (tid & 7) * 8;
    const u16* gb = Bt + (size_t)(n0 + (tid >> 3)) * ldb + (tid & 7) * 8;
    const int soff = ((tid >> 3) * LROW + (tid & 7) * 8) * 2;
    const int aoff = ((128 * wm + r) * LROW + 8 * h) * 2, boff = A4_B + ((64 * wn + pi32(r)) * LROW + 8 * h) * 2;
    u32x4 ra[8], rb[4];
    f32x16 acc[4][2];
#pragma unroll
    for (int a = 0; a < 4; ++a)
#pragma unroll
        for (int b = 0; b < 2; ++b) acc[a][b] = zero16();
    const int nk = K >> 6;
#pragma unroll
    for (int i = 0; i < 8; ++i) ra[i] = *(const u32x4*)(ga + (size_t)(32 * i) * lda);
#pragma unroll
    for (int i = 0; i < 4; ++i) rb[i] = *(const u32x4*)(gb + (size_t)(32 * i) * ldb);
    for (int kt = 0; kt < nk; ++kt) {
        __syncthreads();
#pragma unroll
        for (int i = 0; i < 8; ++i) *(u32x4*)(lds + soff + i * 32 * LROW * 2) = ra[i];
#pragma unroll
        for (int i = 0; i < 4; ++i) *(u32x4*)(lds + A4_B + soff + i * 32 * LROW * 2) = rb[i];
        __syncthreads();
        {
            const int k0 = (kt + 1 < nk ? kt + 1 : kt) * 64;
#pragma unroll
            for (int i = 0; i < 8; ++i) ra[i] = *(const u32x4*)(ga + (size_t)(32 * i) * lda + k0);
#pragma unroll
            for (int i = 0; i < 4; ++i) rb[i] = *(const u32x4*)(gb + (size_t)(32 * i) * ldb + k0);
        }
        __builtin_amdgcn_sched_barrier(0);
#pragma unroll
        for (int s = 0; s < 4; ++s) {
            bf16x8 af[4], bfr[2];
#pragma unroll
            for (int mi = 0; mi < 4; ++mi) af[mi] = *(const bf16x8*)(lds + aoff + mi * 32 * LROW * 2 + s * 32);
#pragma unroll
            for (int ni = 0; ni < 2; ++ni) bfr[ni] = *(const bf16x8*)(lds + boff + ni * 32 * LROW * 2 + s * 32);
#pragma unroll
            for (int mi = 0; mi < 4; ++mi)
#pragma unroll
                for (int ni = 0; ni < 2; ++ni) acc[mi][ni] = MFMA32(bfr[ni], af[mi], acc[mi][ni]);
        }
    }
    epi.template operator()<4>(acc, m0 + 128 * wm, n0 + 64 * wn, r, h);
}


constexpr int G5_A = 256 * 64, G5_B = 128 * 64, G5_ST = G5_A + G5_B;
static_assert(3 * G5_ST <= LDS_BYTES, "tile5 lds");
template <class Epi>
DI void gemm_tile5(unsigned char* ldsg, const u16* __restrict__ A, int lda, const u16* __restrict__ Bt, int ldb, int K, int m0, int n0, const Epi& epi) {
    LAS unsigned char* lds = (LAS unsigned char*)ldsg;
    const int tid = otid(), lane = tid & 63, wave = __builtin_amdgcn_readfirstlane(tid >> 6), wm = wave >> 1, wn = wave & 1, r = lane & 31, h = lane >> 5;
    const int gl_row = lane >> 2, gl_c = (lane & 3) ^ ((lane >> 4) & 3);
    const u16* gA = A + (size_t)(m0 + 64 * wave + gl_row) * lda + gl_c * 8;
    const u16* gB = Bt + (size_t)(n0 + 32 * wave + gl_row) * ldb + gl_c * 8;
    const int ldsA = wave * 4096, ldsB = G5_A + wave * 2048;
    const int xa = (r >> 2) & 3, pr = pi32(r), xb = (pr >> 2) & 3;
    const int a0 = (128 * wm + r) * 64 + ((h ^ xa) << 4), a1 = (128 * wm + r) * 64 + (((2 + h) ^ xa) << 4);
    const int b0 = G5_A + (64 * wn + pr) * 64 + ((h ^ xb) << 4), b1 = G5_A + (64 * wn + pr) * 64 + (((2 + h) ^ xb) << 4);
    f32x16 acc[4][2];
#pragma unroll
    for (int a = 0; a < 4; ++a)
#pragma unroll
        for (int b = 0; b < 2; ++b) acc[a][b] = zero16();
    const int nk = K >> 5;
#define G5_ISSUE(so_, kt_) do { const int k0_ = ((kt_) < nk ? (kt_) : nk - 1) * 32; \
        _Pragma("unroll") for (int j = 0; j < 4; ++j) __builtin_amdgcn_global_load_lds((const unsigned*)(gA + (size_t)(16 * j) * lda + k0_), (LAS unsigned*)(lds + (so_) + ldsA + j * 1024), 16, 0, 0); \
        _Pragma("unroll") for (int j = 0; j < 2; ++j) __builtin_amdgcn_global_load_lds((const unsigned*)(gB + (size_t)(16 * j) * ldb + k0_), (LAS unsigned*)(lds + (so_) + ldsB + j * 1024), 16, 0, 0); } while (0)
    int st_cur = 0, st_nxt = G5_ST, st_wr = 2 * G5_ST;
    G5_ISSUE(st_cur, 0);
    G5_ISSUE(st_nxt, 1);
    asm volatile("s_waitcnt vmcnt(6)" ::: "memory");
    __builtin_amdgcn_s_barrier();
    asm volatile("" ::: "memory");
    for (int kt = 0; kt < nk; ++kt) {
        G5_ISSUE(st_wr, kt + 2);
        {
            bf16x8 af[2][4], bfr[2][2];
#pragma unroll
            for (int ni = 0; ni < 2; ++ni) { bfr[0][ni] = *(const LAS bf16x8*)(lds + st_cur + b0 + ni * 2048); }
#pragma unroll
            for (int mi = 0; mi < 4; ++mi) { af[0][mi] = *(const LAS bf16x8*)(lds + st_cur + a0 + mi * 2048); }
#pragma unroll
            for (int ni = 0; ni < 2; ++ni) { bfr[1][ni] = *(const LAS bf16x8*)(lds + st_cur + b1 + ni * 2048); }
#pragma unroll
            for (int mi = 0; mi < 4; ++mi) { af[1][mi] = *(const LAS bf16x8*)(lds + st_cur + a1 + mi * 2048); }
            __builtin_amdgcn_sched_barrier(0);
            __builtin_amdgcn_s_setprio(1);
#pragma unroll
            for (int s = 0; s < 2; ++s)
#pragma unroll
                for (int mi = 0; mi < 4; ++mi)
#pragma unroll
                    for (int ni = 0; ni < 2; ++ni) acc[mi][ni] = MFMA32(bfr[s][ni], af[s][mi], acc[mi][ni]);
            __builtin_amdgcn_s_setprio(0);
            __builtin_amdgcn_sched_barrier(0);
        }
        asm volatile("s_waitcnt vmcnt(6)" ::: "memory");
        __builtin_amdgcn_s_barrier();
        asm volatile("" ::: "memory");
        { const int t_ = st_cur; st_cur = st_nxt; st_nxt = st_wr; st_wr = t_; }
    }
    asm volatile("s_waitcnt vmcnt(0)" ::: "memory");
    __builtin_amdgcn_s_barrier();
    asm volatile("" ::: "memory");
#undef G5_ISSUE
    if constexpr (Epi::STAGED == 1) {
        epi.template staged<4>(acc, m0 + 128 * wm, n0 + 64 * wn, r, h, ldsg + wave * (32 * 68 * 4), lane);
        __builtin_amdgcn_s_barrier();
        asm volatile("" ::: "memory");
    } else if constexpr (Epi::STAGED == 2) {
        epi.template stage<4>(acc, wm, wn, m0, n0, r, h, ldsg);
        __syncthreads();
        epi.flush(m0, n0, tid, ldsg);
        __syncthreads();
    } else {
        epi.template operator()<4>(acc, m0 + 128 * wm, n0 + 64 * wn, r, h);
    }
}

template <int GW>
DI void tile_of(int lt, int nmx, int ntiles, int& mj, int& n) {
    const int gsz = nmx * GW, g = lt / gsz, rem = lt - g * gsz;
    const int w = (ntiles - GW * g) < GW ? (ntiles - GW * g) : GW;
    mj = rem / w; n = GW * g + rem - mj * w;
}
template <class Epi>
DI void gemm_phase4(unsigned char* lds, const u16* A, int lda, const u16* Bt, int ldb, int K, int mtiles, int ntiles, const Epi& epi) {
    const int G = gridDim.x;
    if ((G & 7) == 0) {
        const int xcd = blockIdx.x & 7, local = blockIdx.x >> 3, nlocal = G >> 3;
        const int nmx = (mtiles - xcd + 7) >> 3, total = nmx * ntiles;
        for (int lt = local; lt < total; lt += nlocal) { int mj, n; tile_of<8>(lt, nmx, ntiles, mj, n); gemm_tile5(lds, A, lda, Bt, ldb, K, (xcd + 8 * mj) * 256, n * 128, epi); }
    } else {
        for (int t = blockIdx.x; t < mtiles * ntiles; t += G) gemm_tile5(lds, A, lda, Bt, ldb, K, (t / ntiles) * 256, (t % ntiles) * 128, epi);
    }
}

struct EpiProj {
    static constexpr int STAGED = 2;
    static constexpr int ROWB = 272;
    u16* proj; const float* ropec; const float* ropes;
    template <int MI> DI void stage(const f32x16 (&acc)[MI][2], int wm, int wn, int m0, int n0, int r, int h, unsigned char* lds) const {
        const int nb = n0 + 64 * wn;
        const bool isq = nb >= C_Q && nb < C_K, isk = nb >= C_K && nb < C_V;
        const float qs = isq ? 0.125f * LOG2E : 1.f;
#pragma unroll
        for (int mi = 0; mi < MI; ++mi) {
            const int rl = 128 * wm + 32 * mi + r, row = m0 + rl;
            const bool rope = (isq || isk) && row < MLAT;
            const int t = row & (SEQ - 1);
#pragma unroll
            for (int ni = 0; ni < 2; ++ni) {
                float lo[8], hi[8];
#pragma unroll
                for (int j = 0; j < 8; ++j) { lo[j] = acc[mi][ni][j]; hi[j] = acc[mi][ni][8 + j]; }
                if (rope) {
                    const int pos = ni == 0 ? (t >> 6) : (t & 63);
                    const float* cp = ropec + pos * 16 + 8 * h; const float* sp = ropes + pos * 16 + 8 * h;
#pragma unroll
                    for (int j = 0; j < 8; ++j) { const float c = cp[j], s = sp[j], x1 = lo[j], x2 = hi[j]; lo[j] = x1 * c - x2 * s; hi[j] = x2 * c + x1 * s; }
                }
                if (isq) {
#pragma unroll
                    for (int j = 0; j < 8; ++j) { lo[j] *= qs; hi[j] *= qs; }
                }
                unsigned char* d = lds + rl * ROWB + (64 * wn + 32 * ni + 8 * h) * 2;
                *(u32x4*)d = pack8(lo); *(u32x4*)(d + 32) = pack8(hi);
            }
        }
    }
    DI void flush(int m0, int n0, int tid, const unsigned char* lds) const {
#pragma unroll
        for (int k = 0; k < 16; ++k) {
            const int id = tid + 256 * k, row = id >> 4, c = id & 15;
            const u32x4 v = *(const u32x4*)(lds + row * ROWB + c * 16);
            if (n0 + 8 * c < NIN) *(u32x4*)(proj + (size_t)(m0 + row) * NIN + n0 + 8 * c) = v;
        }
    }
    template <int MI> DI void operator()(const f32x16 (&acc)[MI][2], int mb, int nb, int r, int h) const {
        const bool isq = nb >= C_Q && nb < C_K, isk = nb >= C_K && nb < C_V;
        const float qs = isq ? 0.125f * LOG2E : 1.f;
#pragma unroll
        for (int mi = 0; mi < MI; ++mi) {
            const int row = mb + 32 * mi + r;
            u16* rp = proj + (size_t)row * NIN;
            const bool rope = (isq || isk) && row < MLAT;
            const int t = row & (SEQ - 1);
#pragma unroll
            for (int ni = 0; ni < 2; ++ni) {
                float lo[8], hi[8];
#pragma unroll
                for (int j = 0; j < 8; ++j) { lo[j] = acc[mi][ni][j]; hi[j] = acc[mi][ni][8 + j]; }
                if (rope) {
                    const int pos = ni == 0 ? (t >> 6) : (t & 63);
                    const float* cp = ropec + pos * 16 + 8 * h; const float* sp = ropes + pos * 16 + 8 * h;
#pragma unroll
                    for (int j = 0; j < 8; ++j) { const float c = cp[j], s = sp[j], x1 = lo[j], x2 = hi[j]; lo[j] = x1 * c - x2 * s; hi[j] = x2 * c + x1 * s; }
                }
                if (isq) {
#pragma unroll
                    for (int j = 0; j < 8; ++j) { lo[j] *= qs; hi[j] *= qs; }
                }
                const int n = nb + 32 * ni + 8 * h;
                if (n < NIN) *(u32x4*)(rp + n) = pack8(lo);
                if (n + 16 < NIN) *(u32x4*)(rp + n + 16) = pack8(hi);
            }
        }
    }
};
struct EpiResid {
    static constexpr int STAGED = 1;
    const float* src_lat; const float* src_ctx; float* dst_lat; float* dst_ctx; const float* gate;
    template <int MI> DI void staged(const f32x16 (&acc)[MI][2], int mb, int nb, int r, int h, unsigned char* wl, int lane) const {
        const int var = mb < SEQ ? 0 : (mb < MLAT ? 1 : 2);
        const int rr = lane >> 4, c4 = (lane & 15) * 4;
        const f32x4 gt = *(const f32x4*)(gate + var * 6 * D + nb + c4);
        float* W = (float*)wl;
#pragma unroll
        for (int mi = 0; mi < MI; ++mi) {
#pragma unroll
            for (int ni = 0; ni < 2; ++ni)
#pragma unroll
                for (int g = 0; g < 2; ++g) {
                    float* d = W + r * 68 + 32 * ni + 16 * g + 8 * h;
                    f32x4 v0, v1;
                    v0.x = acc[mi][ni][8 * g]; v0.y = acc[mi][ni][8 * g + 1]; v0.z = acc[mi][ni][8 * g + 2]; v0.w = acc[mi][ni][8 * g + 3];
                    v1.x = acc[mi][ni][8 * g + 4]; v1.y = acc[mi][ni][8 * g + 5]; v1.z = acc[mi][ni][8 * g + 6]; v1.w = acc[mi][ni][8 * g + 7];
                    *(f32x4*)d = v0; *(f32x4*)(d + 4) = v1;
                }
            asm volatile("s_waitcnt lgkmcnt(0)" ::: "memory");
#pragma unroll
            for (int it = 0; it < 8; ++it) {
                const int rl = 4 * it + rr, row = mb + 32 * mi + rl;
                const f32x4 a = *(const f32x4*)(W + rl * 68 + c4);
                const float* sp = row < MLAT ? src_lat + (size_t)row * D : src_ctx + (size_t)(row - MLAT) * D;
                float* dp = row < MLAT ? dst_lat + (size_t)row * D : dst_ctx + (size_t)(row - MLAT) * D;
                const f32x4 s = *(const f32x4*)(sp + nb + c4);
                f32x4 o; o.x = s.x + gt.x * a.x; o.y = s.y + gt.y * a.y; o.z = s.z + gt.z * a.z; o.w = s.w + gt.w * a.w;
                *(f32x4*)(dp + nb + c4) = o;
            }
            asm volatile("s_waitcnt lgkmcnt(0)" ::: "memory");
        }
    }
    template <int MI> DI void operator()(const f32x16 (&acc)[MI][2], int mb, int nb, int r, int h) const {
        const int var = mb < SEQ ? 0 : (mb < MLAT ? 1 : 2);
        const float* gv = gate + var * 6 * D;
#pragma unroll
        for (int mi = 0; mi < MI; ++mi) {
            const int row = mb + 32 * mi + r;
            const float* sp = row < MLAT ? src_lat + (size_t)row * D : src_ctx + (size_t)(row - MLAT) * D;
            float* dp = row < MLAT ? dst_lat + (size_t)row * D : dst_ctx + (size_t)(row - MLAT) * D;
#pragma unroll
            for (int ni = 0; ni < 2; ++ni)
#pragma unroll
                for (int g = 0; g < 2; ++g) {
                    const int n = nb + 32 * ni + 16 * g + 8 * h;
#pragma unroll
                    for (int q = 0; q < 2; ++q) {
                        const f32x4 s = *(const f32x4*)(sp + n + 4 * q), gt = *(const f32x4*)(gv + n + 4 * q);
                        f32x4 o; o.x = s.x + gt.x * acc[mi][ni][8 * g + 4 * q]; o.y = s.y + gt.y * acc[mi][ni][8 * g + 4 * q + 1];
                        o.z = s.z + gt.z * acc[mi][ni][8 * g + 4 * q + 2]; o.w = s.w + gt.w * acc[mi][ni][8 * g + 4 * q + 3];
                        *(f32x4*)(dp + n + 4 * q) = o;
                    }
                }
        }
    }
};
struct EpiPartial {
    float* part;
    template <int MI> DI void operator()(const f32x16 (&acc)[MI][2], int mb, int nb, int r, int h) const {
#pragma unroll
        for (int mi = 0; mi < MI; ++mi) {
            float* dp = part + (size_t)(mb + 32 * mi + r - MLAT) * D;
#pragma unroll
            for (int ni = 0; ni < 2; ++ni)
#pragma unroll
                for (int g = 0; g < 2; ++g) {
                    const int n = nb + 32 * ni + 16 * g + 8 * h;
                    f32x4 v0, v1;
                    v0.x = acc[mi][ni][8 * g]; v0.y = acc[mi][ni][8 * g + 1]; v0.z = acc[mi][ni][8 * g + 2]; v0.w = acc[mi][ni][8 * g + 3];
                    v1.x = acc[mi][ni][8 * g + 4]; v1.y = acc[mi][ni][8 * g + 5]; v1.z = acc[mi][ni][8 * g + 6]; v1.w = acc[mi][ni][8 * g + 7];
                    *(f32x4*)(dp + n) = v0; *(f32x4*)(dp + n + 4) = v1;
                }
        }
    }
};
struct EpiSwiglu {
    static constexpr int STAGED = 2;
    static constexpr int ROWB = 144;
    u16* hb;
    template <int MI> DI void stage(const f32x16 (&acc)[MI][2], int wm, int wn, int m0, int n0, int r, int h, unsigned char* lds) const {
#pragma unroll
        for (int mi = 0; mi < MI; ++mi) {
            const int rl = 128 * wm + 32 * mi + r;
#pragma unroll
            for (int g = 0; g < 2; ++g) {
                float f[8];
#pragma unroll
                for (int j = 0; j < 8; ++j) f[j] = siluf(acc[mi][0][8 * g + j]) * acc[mi][1][8 * g + j];
                *(u32x4*)(lds + rl * ROWB + (32 * wn + 16 * g + 8 * h) * 2) = pack8(f);
            }
        }
    }
    DI void flush(int m0, int n0, int tid, const unsigned char* lds) const {
#pragma unroll
        for (int k = 0; k < 8; ++k) {
            const int id = tid + 256 * k, row = id >> 3, c = id & 7;
            *(u32x4*)(hb + (size_t)(m0 + row) * DFF + (n0 >> 1) + 8 * c) = *(const u32x4*)(lds + row * ROWB + c * 16);
        }
    }
    template <int MI> DI void operator()(const f32x16 (&acc)[MI][2], int mb, int nb, int r, int h) const {
#pragma unroll
        for (int mi = 0; mi < MI; ++mi) {
            u16* rp = hb + (size_t)(mb + 32 * mi + r) * DFF + (nb >> 1);
#pragma unroll
            for (int g = 0; g < 2; ++g) {
                float f[8];
#pragma unroll
                for (int j = 0; j < 8; ++j) f[j] = siluf(acc[mi][0][8 * g + j]) * acc[mi][1][8 * g + j];
                *(u32x4*)(rp + 16 * g + 8 * h) = pack8(f);
            }
        }
    }
};

DI void attn_unit(unsigned char* lds, const Params& p, int l, int u) {
    const u16* proj = (const u16*)(p.ws + OFF_PROJ);
    u16* cat = (u16*)(p.ws + OFF_CAT);
    const float* ropec = (const float*)(p.ws + OFF_ROPE);
    const float* ropes = ropec + 4096;
    u16* Ks = (u16*)lds; u16* Vt = (u16*)(lds + T64_B);
    const int tid = otid(), lane = tid & 63, wave = tid >> 6, r = lane & 31, h = lane >> 5;
    const bool isctx = u >= 2048;
    int b, hd, qb;
    if (!isctx) { qb = u & 127; hd = (u >> 7) & 7; b = u >> 10; } else { const int cu = u - 2048; qb = cu & 1; hd = (cu >> 1) & 7; b = cu >> 4; }
    const int kvh = hd >> 2;
    const int q0 = 128 * qb + 32 * wave;
    const size_t qrow = (size_t)(isctx ? MLAT + b * CTX : b * SEQ) + q0 + r;
    bf16x8 qf[4];
#pragma unroll
    for (int s = 0; s < 4; ++s) qf[s] = __builtin_bit_cast(bf16x8, *(const u32x4*)(proj + qrow * NIN + C_Q + hd * 64 + 16 * s + 8 * h));
    float m = p.sink[l * 8 + hd] * LOG2E;
    float lsum = (h == 0) ? 1.f : 0.f;
    f32x16 O0 = zero16(), O1 = zero16();
    const int ntiles = isctx ? 4 : 10;
    for (int tile = 0; tile < ntiles; ++tile) {
        const bool local = tile >= 4;
        int tk0 = 0; size_t krow0;
        if (!local) krow0 = (size_t)MLAT + b * CTX + 64 * tile;
        else { tk0 = 128 * qb - 128 + 64 * (tile - 4); if (tk0 < 0 || tk0 >= SEQ) continue; krow0 = (size_t)b * SEQ + tk0; }
        __syncthreads();
        {
            const int key = tid >> 2, part = tid & 3, half = part >> 1, sub = part & 1;
            const u16* kp = proj + (krow0 + key) * NIN + C_K + kvh * 64 + 32 * half + 8 * sub;
            u32x4 w1 = *(const u32x4*)kp, w2 = *(const u32x4*)(kp + 16);
            *(u32x4*)(Ks + key * LROW + 32 * half + 8 * sub) = w1;
            *(u32x4*)(Ks + key * LROW + 32 * half + 16 + 8 * sub) = w2;
        }
        {
            const int key = tid & 63, dc = tid >> 6;
            const u16* vp = proj + (krow0 + key) * NIN + C_V + kvh * 64 + 16 * dc;
            const u32x4 v0 = *(const u32x4*)vp, v1 = *(const u32x4*)(vp + 8);
            const unsigned wv[8] = {v0.x, v0.y, v0.z, v0.w, v1.x, v1.y, v1.z, v1.w};
#pragma unroll
            for (int i = 0; i < 8; ++i) { Vt[(16 * dc + 2 * i) * LROW + key] = (u16)(wv[i] & 0xffffu); Vt[(16 * dc + 2 * i + 1) * LROW + key] = (u16)(wv[i] >> 16); }
        }
        __syncthreads();
        if (local && (tk0 + 63 < q0 - 128 || tk0 > q0 + 31 + 128)) continue;
        const bool needmask = local && !(tk0 >= q0 + 31 - 128 && tk0 + 63 <= q0 + 128);
#pragma unroll
        for (int sub = 0; sub < 2; ++sub) {
            f32x16 s0 = zero16();
#pragma unroll
            for (int s = 0; s < 4; ++s) {
                const bf16x8 ka0 = *(const bf16x8*)(Ks + (32 * sub + pi32(r)) * LROW + 16 * s + 8 * h);
                s0 = MFMA32(ka0, qf[s], s0);
            }
            if (needmask) {
                const int tq = q0 + r;
#pragma unroll
                for (int i = 0; i < 16; ++i) {
                    const int tk = tk0 + 32 * sub + 16 * (i >> 3) + 8 * h + (i & 7);
                    const int d0 = tq - tk;
                    if (d0 > 128 || d0 < -128) s0[i] = -INFINITY;
                }
            }
            float mx = s0[0];
#pragma unroll
            for (int i = 1; i < 16; ++i) mx = fmaxf(mx, s0[i]);
            mx = fmaxf(mx, __shfl_xor(mx, 32));
            const float mn = fmaxf(m, mx);
            const float alpha = __builtin_amdgcn_exp2f(m - mn);
            m = mn;
            float ps = 0.f;
#pragma unroll
            for (int i = 0; i < 16; ++i) { s0[i] = __builtin_amdgcn_exp2f(s0[i] - mn); ps += s0[i]; }
            lsum = lsum * alpha + ps;
            if (__builtin_amdgcn_ballot_w64(alpha != 1.f) != 0ull) {
#pragma unroll
                for (int i = 0; i < 16; ++i) { O0[i] *= alpha; O1[i] *= alpha; }
            }
            bf16x8 pf[2];
            {
                u32x4 w;
                w.x = pk2(s0[0], s0[1]); w.y = pk2(s0[2], s0[3]); w.z = pk2(s0[4], s0[5]); w.w = pk2(s0[6], s0[7]); pf[0] = __builtin_bit_cast(bf16x8, w);
                w.x = pk2(s0[8], s0[9]); w.y = pk2(s0[10], s0[11]); w.z = pk2(s0[12], s0[13]); w.w = pk2(s0[14], s0[15]); pf[1] = __builtin_bit_cast(bf16x8, w);
            }
#pragma unroll
            for (int ks = 0; ks < 2; ++ks) {
                const bf16x8 va0 = *(const bf16x8*)(Vt + r * LROW + 32 * sub + 16 * ks + 8 * h);
                const bf16x8 va1 = *(const bf16x8*)(Vt + (32 + r) * LROW + 32 * sub + 16 * ks + 8 * h);
                O0 = MFMA32(va0, pf[ks], O0); O1 = MFMA32(va1, pf[ks], O1);
            }
        }
    }
    const float lt = lsum + __shfl_xor(lsum, 32);
    const float inv = 1.f / lt;
    {
        unsigned char* patch = lds + 20480 + wave * (32 * 144);
#pragma unroll
        for (int g4 = 0; g4 < 4; ++g4) {
            u32x2 w0, w1;
            w0.x = pk2(O0[4 * g4] * inv, O0[4 * g4 + 1] * inv); w0.y = pk2(O0[4 * g4 + 2] * inv, O0[4 * g4 + 3] * inv);
            w1.x = pk2(O1[4 * g4] * inv, O1[4 * g4 + 1] * inv); w1.y = pk2(O1[4 * g4 + 2] * inv, O1[4 * g4 + 3] * inv);
            *(u32x2*)(patch + r * 144 + (8 * g4 + 4 * h) * 2) = w0;
            *(u32x2*)(patch + r * 144 + (32 + 8 * g4 + 4 * h) * 2) = w1;
        }
        asm volatile("s_waitcnt lgkmcnt(0)" ::: "memory");
        u16* ob = cat + (qrow - r) * D + 256 + hd * 64;
#pragma unroll
        for (int it = 0; it < 4; ++it) {
            const int row = 8 * it + (lane >> 3), c = lane & 7;
            *(u32x4*)(ob + (size_t)row * D + 8 * c) = *(const u32x4*)(patch + row * 144 + c * 16);
        }
        asm volatile("s_waitcnt lgkmcnt(0)" ::: "memory");
    }
}

DI void conv_unit(const Params& p, int l, int u) {
    const u16* proj = (const u16*)(p.ws + OFF_PROJ);
    u16* cat = (u16*)(p.ws + OFF_CAT);
    const float* cw = p.conv_w + l * 3 * 256;
    const int tid = otid();
#pragma unroll
    for (int i = 0; i < 4; ++i) {
        const int item = tid + 256 * i, rr = item >> 5, ch = (item & 31) * 8;
        const int row = 32 * u + rr;
        int t, len;
        if (row < MLAT) { t = row & (SEQ - 1); len = SEQ; } else { t = (row - MLAT) & (CTX - 1); len = CTX; }
        const u16* rp = proj + (size_t)row * NIN;
        float y[8];
#pragma unroll
        for (int j = 0; j < 8; ++j) y[j] = 0.f;
#pragma unroll
        for (int tap = 0; tap < 3; ++tap) {
            const int tt = t + tap - 1;
            if (tt >= 0 && tt < len) {
                const u16* np_ = rp + (ptrdiff_t)(tap - 1) * NIN;
                float xi[8], cg_[8]; unpack8(*(const u32x4*)(np_ + C_CX + ch), xi); unpack8(*(const u32x4*)(np_ + C_CC + ch), cg_);
                const f32x4 wa = *(const f32x4*)(cw + tap * 256 + ch), wb2 = *(const f32x4*)(cw + tap * 256 + ch + 4);
                const float w8[8] = {wa.x, wa.y, wa.z, wa.w, wb2.x, wb2.y, wb2.z, wb2.w};
#pragma unroll
                for (int j = 0; j < 8; ++j) y[j] += w8[j] * (cg_[j] * xi[j]);
            }
        }
        float bg[8]; unpack8(*(const u32x4*)(rp + C_CB + ch), bg);
#pragma unroll
        for (int j = 0; j < 8; ++j) y[j] *= bg[j];
        *(u32x4*)(cat + (size_t)row * D + ch) = pack8(y);
    }
}

constexpr int GL_G = 0, GL_LR = 16384, GL_GW = 20480, GL_GB = 24576, GL_QS = 24832, GL_BL = 25856, GL_T0 = 26112;
static_assert(GL_T0 + 5 * T64_B <= LDS_BYTES, "gla lds");

struct GateRegs { u32x2 lr; f32x4 gw; float gb; };
DI GateRegs gla_gate_load(const Params& p, int l, int dir, int hh, size_t row0, int tid) {
    const u16* proj = (const u16*)(p.ws + OFF_PROJ);
    GateRegs g;
    const int tok = tid >> 2, part = tid & 3;
    g.lr = *(const u32x2*)(proj + (row0 + tok) * NIN + C_LR + 16 * dir + 4 * part);
    const int rr = tid >> 4, k4 = (tid & 15) * 4;
    g.gw = *(const f32x4*)(p.gate_w + ((size_t)(l * 2 + dir) * 16 + rr) * 256 + hh * 64 + k4);
    g.gb = p.gate_b[(l * 2 + dir) * 256 + hh * 64 + (tid & 63)];
    return g;
}
DI void gla_gates(unsigned char* lds, const GateRegs& gr, int dir) {
    float* G = (float*)(lds + GL_G); float* LR = (float*)(lds + GL_LR); float* GW = (float*)(lds + GL_GW);
    float* GB = (float*)(lds + GL_GB); float* QS = (float*)(lds + GL_QS); float* BL = (float*)(lds + GL_BL);
    const int tid = otid();
    {
        const int tok = tid >> 2, part = tid & 3;
        const u32x2 w = gr.lr;
        f32x4 f; f.x = bflo(w.x); f.y = bfhi(w.x); f.z = bflo(w.y); f.w = bfhi(w.y);
        *(f32x4*)(LR + tok * 16 + 4 * part) = f;
        const int rr = tid >> 4, k4 = (tid & 15) * 4;
        *(f32x4*)(GW + rr * 64 + k4) = gr.gw;
        if (tid < 64) GB[tid] = gr.gb;
    }
    __syncthreads();
    const int k = tid & 63, q = tid >> 6;
    float gwr[16];
#pragma unroll
    for (int rr = 0; rr < 16; ++rr) gwr[rr] = GW[rr * 64 + k];
    const float gb = GB[k];
    float run = 0.f;
#pragma unroll 4
    for (int i = 0; i < 16; ++i) {
        const int t = dir ? (16 * q + 15 - i) : (16 * q + i);
        float x = gb;
#pragma unroll
        for (int r4 = 0; r4 < 4; ++r4) { const f32x4 lv = *(const f32x4*)(LR + t * 16 + 4 * r4); x += lv.x * gwr[4 * r4] + lv.y * gwr[4 * r4 + 1] + lv.z * gwr[4 * r4 + 2] + lv.w * gwr[4 * r4 + 3]; }
        const float ls = fminf(x, 0.f) - __logf(1.f + __expf(-fabsf(x)));
        run += ls * (1.f / 16.f);
        G[t * 64 + k] = run;
    }
    QS[q * 64 + k] = run;
    __syncthreads();
    float off = 0.f, tot = 0.f;
#pragma unroll
    for (int q2 = 0; q2 < 4; ++q2) { const float v = QS[q2 * 64 + k]; tot += v; if (dir ? (q2 > q) : (q2 < q)) off += v; }
#pragma unroll 4
    for (int i = 0; i < 16; ++i) G[(16 * q + i) * 64 + k] += off;
    if (q == 0) BL[k] = tot;
    __syncthreads();
}

DI void gla_passA_unit(unsigned char* lds, const Params& p, int l, int u) {
    const u16* proj = (const u16*)(p.ws + OFF_PROJ);
    float* GST = (float*)(p.ws + OFF_GST); float* GD = (float*)(p.ws + OFF_GD);
    const float* G = (const float*)(lds + GL_G); const float* BL = (const float*)(lds + GL_BL);
    u16* VT = (u16*)(lds + GL_T0); u16* KT = (u16*)(lds + GL_T0 + T64_B);
    const int tid = otid(), lane = tid & 63, wave = tid >> 6, r = lane & 31, h = lane >> 5;
    const int dir = u & 1, hh = (u >> 1) & 3, cc = u >> 3, b = cc / NCH, jj = cc % NCH;
    const bool isctx = jj < 4; const int j = isctx ? jj : jj - 4;
    const size_t row0 = isctx ? (size_t)MLAT + b * CTX + 64 * j : (size_t)b * SEQ + 64 * j;
    const int c = isctx ? (dir ? 3 - j : j) : 4 + (dir ? 255 - j : j);
    const int seq = (b * 4 + hh) * 2 + dir;
    const GateRegs gr = gla_gate_load(p, l, dir, hh, row0, tid);
    u32x4 kA0, kA1, v0, v1;
    {
        const int tok = tid >> 2, part = tid & 3;
        const u16* kp = proj + (row0 + tok) * NIN + C_GK + hh * 64 + 16 * part;
        const u16* vp = proj + (row0 + tok) * NIN + C_GV + hh * 64 + 16 * part;
        kA0 = *(const u32x4*)kp; kA1 = *(const u32x4*)(kp + 8); v0 = *(const u32x4*)vp; v1 = *(const u32x4*)(vp + 8);
    }
    __syncthreads();
    gla_gates(lds, gr, dir);
    {
        const int tok = tid >> 2, part = tid & 3;
        float kf[16]; { float t0[8], t1[8]; unpack8(kA0, t0); unpack8(kA1, t1);
#pragma unroll
            for (int i = 0; i < 8; ++i) { kf[i] = t0[i]; kf[8 + i] = t1[i]; } }
        const unsigned wv[8] = {v0.x, v0.y, v0.z, v0.w, v1.x, v1.y, v1.z, v1.w};
#pragma unroll
        for (int i = 0; i < 16; ++i) {
            const int kk = 16 * part + i;
            const float e = __expf(BL[kk] - G[tok * 64 + kk]);
            KT[kk * LROW + tok] = f2bf(kf[i] * e);
            VT[kk * LROW + tok] = (u16)((i & 1) ? (wv[i >> 1] >> 16) : (wv[i >> 1] & 0xffffu));
        }
    }
    __syncthreads();
    const int ti = wave >> 1, tj = wave & 1;
    f32x16 acc = zero16();
#pragma unroll
    for (int s = 0; s < 4; ++s) {
        const bf16x8 a = *(const bf16x8*)(KT + (32 * ti + r) * LROW + 16 * s + 8 * h);
        const bf16x8 bb = *(const bf16x8*)(VT + (32 * tj + r) * LROW + 16 * s + 8 * h);
        acc = MFMA32(a, bb, acc);
    }
    float* st = GST + ((size_t)seq * NCH + c) * 4096;
#pragma unroll
    for (int i = 0; i < 16; ++i) st[(32 * ti + crow(i, h)) * 64 + 32 * tj + r] = acc[i];
    if (tid < 64) GD[((size_t)seq * NCH + c) * 64 + tid] = __expf(BL[tid]);
}

DI void gla_scan_phase(const Params& p) {
    float* GST = (float*)(p.ws + OFF_GST); const float* GD = (const float*)(p.ws + OFF_GD);
    const int tid = otid();
    for (int g = blockIdx.x * 256 + tid; g < 16 * 4096; g += gridDim.x * 256) {
        const int seq = g >> 12, e = g & 4095, dk = e >> 6;
        float* st = GST + (size_t)seq * NCH * 4096 + e;
        const float* gd = GD + (size_t)seq * NCH * 64 + dk;
        float S = 0.f;
        for (int c0 = 0; c0 < NCH; c0 += 20) {
            float uu[20], dd[20];
#pragma unroll
            for (int i = 0; i < 20; ++i) { uu[i] = st[(size_t)(c0 + i) * 4096]; dd[i] = gd[(c0 + i) * 64]; }
#pragma unroll
            for (int i = 0; i < 20; ++i) { st[(size_t)(c0 + i) * 4096] = S; S = dd[i] * S + uu[i]; }
        }
    }
}

DI void gla_passC_unit(unsigned char* lds, const Params& p, int l, int u) {
    const u16* proj = (const u16*)(p.ws + OFF_PROJ);
    u16* cat = (u16*)(p.ws + OFF_CAT);
    const float* GST = (const float*)(p.ws + OFF_GST);
    float* G = (float*)(lds + GL_G); const float* BL = (const float*)(lds + GL_BL);
    u16* VT = (u16*)(lds + GL_T0); u16* QT = (u16*)(lds + GL_T0 + T64_B); u16* KK = (u16*)(lds + GL_T0 + 2 * T64_B);
    u16* QB = (u16*)(lds + GL_T0 + 3 * T64_B); u16* SST = (u16*)(lds + GL_T0 + 4 * T64_B); u16* AM = QT;
    const int tid = otid(), lane = tid & 63, wave = tid >> 6, r = lane & 31, h = lane >> 5;
    const int hh = u & 3, cc = u >> 2, b = cc / NCH, jj = cc % NCH;
    const bool isctx = jj < 4; const int j = isctx ? jj : jj - 4;
    if (l == DEPTH - 1 && isctx) return;
    const size_t row0 = isctx ? (size_t)MLAT + b * CTX + 64 * j : (size_t)b * SEQ + 64 * j;
    GateRegs grd[2]; u32x4 qr[2], kr[2], v0, v1, ggr[2]; f32x4 sin_[2][4];
    {
        const int tok = tid >> 2, part = tid & 3;
        const u16* rp = proj + (row0 + tok) * NIN + hh * 64 + 16 * part;
        grd[0] = gla_gate_load(p, l, 0, hh, row0, tid); grd[1] = gla_gate_load(p, l, 1, hh, row0, tid);
        qr[0] = *(const u32x4*)(rp + C_GQ); qr[1] = *(const u32x4*)(rp + C_GQ + 8);
        kr[0] = *(const u32x4*)(rp + C_GK); kr[1] = *(const u32x4*)(rp + C_GK + 8);
        v0 = *(const u32x4*)(rp + C_GV); v1 = *(const u32x4*)(rp + C_GV + 8);
        ggr[0] = *(const u32x4*)(rp + C_GG); ggr[1] = *(const u32x4*)(rp + C_GG + 8);
        const int dk = tid >> 2, dvc = (tid & 3) * 16;
#pragma unroll
        for (int d = 0; d < 2; ++d) {
            const int c = isctx ? (d ? 3 - j : j) : 4 + (d ? 255 - j : j);
            const float* sp = GST + ((size_t)((b * 4 + hh) * 2 + d) * NCH + c) * 4096 + dk * 64 + dvc;
#pragma unroll
            for (int q4 = 0; q4 < 4; ++q4) sin_[d][q4] = *(const f32x4*)(sp + 4 * q4);
        }
    }
    __syncthreads();
    {
        const int tok = tid >> 2, part = tid & 3;
        const unsigned wv[8] = {v0.x, v0.y, v0.z, v0.w, v1.x, v1.y, v1.z, v1.w};
#pragma unroll
        for (int i = 0; i < 16; ++i) VT[(16 * part + i) * LROW + tok] = (u16)((i & 1) ? (wv[i >> 1] >> 16) : (wv[i >> 1] & 0xffffu));
    }
    const int ti = wave >> 1, tj = wave & 1;
    f32x16 o = zero16();
#pragma unroll
    for (int dir = 0; dir < 2; ++dir) {
        gla_gates(lds, grd[dir], dir);
        {
            const int tok = tid >> 2, part = tid & 3;
#pragma unroll
            for (int hf = 0; hf < 2; ++hf) {
                float qv[8], kv[8], a[8], bq[8], ck[8];
                unpack8(qr[hf], qv); unpack8(kr[hf], kv);
#pragma unroll
                for (int i = 0; i < 8; ++i) {
                    const int kk = 16 * part + 8 * hf + i;
                    const float bt = G[tok * 64 + kk], mm = 0.5f * BL[kk], qq = qv[i] * 0.125f;
                    a[i] = qq * __expf(bt - mm); ck[i] = kv[i] * __expf(mm - bt); bq[i] = qq * __expf(bt);
                }
                *(u32x4*)(QT + tok * LROW + 16 * part + 8 * hf) = pack8(a);
                *(u32x4*)(KK + tok * LROW + 16 * part + 8 * hf) = pack8(ck);
                *(u32x4*)(QB + tok * LROW + 16 * part + 8 * hf) = pack8(bq);
            }
            const int dk = tid >> 2, dvc = (tid & 3) * 16;
#pragma unroll
            for (int q4 = 0; q4 < 4; ++q4) { const f32x4 sv = sin_[dir][q4];
                SST[(dvc + 4 * q4 + 0) * LROW + dk] = f2bf(sv.x); SST[(dvc + 4 * q4 + 1) * LROW + dk] = f2bf(sv.y);
                SST[(dvc + 4 * q4 + 2) * LROW + dk] = f2bf(sv.z); SST[(dvc + 4 * q4 + 3) * LROW + dk] = f2bf(sv.w); }
        }
        __syncthreads();
        f32x16 am = zero16();
#pragma unroll
        for (int s = 0; s < 4; ++s) {
            const bf16x8 a = *(const bf16x8*)(QT + (32 * ti + r) * LROW + 16 * s + 8 * h);
            const bf16x8 bb = *(const bf16x8*)(KK + (32 * tj + r) * LROW + 16 * s + 8 * h);
            am = MFMA32(a, bb, am);
        }
        __syncthreads();
#pragma unroll
        for (int i = 0; i < 16; ++i) {
            const int t = 32 * ti + crow(i, h), s = 32 * tj + r;
            const bool keep = dir ? (s >= t) : (s <= t);
            AM[t * LROW + s] = f2bf(keep ? am[i] : 0.f);
        }
        __syncthreads();
#pragma unroll
        for (int s = 0; s < 4; ++s) {
            const bf16x8 a = *(const bf16x8*)(AM + (32 * ti + r) * LROW + 16 * s + 8 * h);
            const bf16x8 bb = *(const bf16x8*)(VT + (32 * tj + r) * LROW + 16 * s + 8 * h);
            o = MFMA32(a, bb, o);
            const bf16x8 a2 = *(const bf16x8*)(QB + (32 * ti + r) * LROW + 16 * s + 8 * h);
            const bf16x8 b2 = *(const bf16x8*)(SST + (32 * tj + r) * LROW + 16 * s + 8 * h);
            o = MFMA32(a2, b2, o);
        }
        __syncthreads();
    }
    float* OF = G;
#pragma unroll
    for (int i = 0; i < 16; ++i) OF[(32 * ti + crow(i, h)) * 64 + 32 * tj + r] = o[i];
    __syncthreads();
    {
        const int t = tid >> 2, dvc = (tid & 3) * 16;
        float ov[16]; float ss = 0.f;
#pragma unroll
        for (int q4 = 0; q4 < 4; ++q4) { const f32x4 v = *(const f32x4*)(OF + t * 64 + dvc + 4 * q4); ov[4 * q4] = v.x; ov[4 * q4 + 1] = v.y; ov[4 * q4 + 2] = v.z; ov[4 * q4 + 3] = v.w; ss += v.x * v.x + v.y * v.y + v.z * v.z + v.w * v.w; }
        ss += __shfl_xor(ss, 1); ss += __shfl_xor(ss, 2);
        const float rs = rsqrtf(ss * (1.f / 64.f) + EPS);
        const float* gn = p.gnorm + l * 64 + dvc;
        u16* op = cat + (row0 + t) * D + 768 + hh * 64 + dvc;
#pragma unroll
        for (int hf = 0; hf < 2; ++hf) {
            float gg[8], ou[8]; unpack8(ggr[hf], gg);
#pragma unroll
            for (int i = 0; i < 8; ++i) ou[i] = ov[8 * hf + i] * rs * gn[8 * hf + i] * siluf(gg[i]);
            *(u32x4*)(op + 8 * hf) = pack8(ou);
        }
    }
}

#define XB_TMO      128
#define XB_XCNT(j)  (256  + 64 * (j))
#define XB_XSUB(j)  (1280 + 64 * (j))
#define XB_XGEN(j)  (2304 + 64 * (j))
#define XB_TOP      3328
#define XB_TOPGEN   3392
#define XCD_BAR_WORDS 3456
#define XB_SPIN_CAP (1u << 18)
DI unsigned xb_ld(unsigned* p)              { return __hip_atomic_load(p, __ATOMIC_RELAXED, __HIP_MEMORY_SCOPE_AGENT); }
DI unsigned xb_add(unsigned* p, unsigned v) { return __hip_atomic_fetch_add(p, v, __ATOMIC_RELAXED, __HIP_MEMORY_SCOPE_AGENT); }
DI unsigned xb_xcc_id() { return (unsigned)__builtin_amdgcn_s_getreg((3 << 11) | 20) & 0xFu; }
#define XB_SPIN(cond, bar) do { unsigned _sp = 0; while (cond) { __builtin_amdgcn_s_sleep(1); \
    if ((++_sp & 255u) == 0u) { if (xb_ld(&(bar)[XB_TMO])) break; if (_sp > XB_SPIN_CAP) { atomicAdd(&(bar)[XB_TMO], 1u); break; } } } } while (0)
struct XcdBarrier { unsigned* bar; unsigned x; volatile LAS unsigned* st; };
DI XcdBarrier xcd_barrier_post(unsigned* bar, volatile LAS unsigned* st) {
    XcdBarrier b; b.bar = bar; b.x = xb_xcc_id(); b.st = st;
    if (threadIdx.x == 0) (void)xb_add(&bar[XB_XCNT(b.x)], 1u);
    return b;
}
DI void xcd_barrier_complete(unsigned* bar, unsigned x, unsigned& nloc, unsigned& nx) {
    const unsigned G = gridDim.x * gridDim.y * gridDim.z;
    unsigned sum, cnt, mine, sp = 0u;
    for (;;) {
        sum = 0u; cnt = 0u; mine = 0u;
#pragma unroll
        for (unsigned j = 0; j < 16; ++j) { const unsigned c = xb_ld(&bar[XB_XCNT(j)]); sum += c; cnt += (c > 0u) ? 1u : 0u; mine = (j == x) ? c : mine; }
        if (sum == G) break;
        __builtin_amdgcn_s_sleep(1);
        if ((++sp & 255u) == 0u) { if (xb_ld(&bar[XB_TMO])) break; if (sp > XB_SPIN_CAP) { atomicAdd(&bar[XB_TMO], 1u); break; } }
    }
    nloc = mine > 0u ? mine : 1u; nx = cnt > 0u ? cnt : 1u;
}
DI void xcd_barrier(const XcdBarrier& b) {
    asm volatile("s_waitcnt vmcnt(0)" ::: "memory");
    __syncthreads();
    if (threadIdx.x == 0) {
        unsigned* bar = b.bar;
        __builtin_amdgcn_s_waitcnt(0);
        unsigned nloc = b.st[0], nx = b.st[1];
        if (nloc == 0u) { xcd_barrier_complete(bar, b.x, nloc, nx); b.st[0] = nloc; b.st[1] = nx; }
        const unsigned old = xb_add(&bar[XB_XSUB(b.x)], 1u);
        const unsigned gen = old / nloc;
        if (old + 1u == (gen + 1u) * nloc) {
            __builtin_amdgcn_fence(__ATOMIC_RELEASE, "agent");
            asm volatile("s_waitcnt vmcnt(0)" ::: "memory");
            const unsigned og = xb_add(&bar[XB_TOP], 1u);
            const unsigned tg = og / nx;
            if (og + 1u == (tg + 1u) * nx) xb_add(&bar[XB_TOPGEN], 1u);
            else XB_SPIN(xb_ld(&bar[XB_TOPGEN]) == tg, bar);
            __builtin_amdgcn_fence(__ATOMIC_ACQUIRE, "agent");
            xb_add(&bar[XB_XGEN(b.x)], 1u);
            asm volatile("s_waitcnt vmcnt(0)" ::: "memory");
        } else {
            XB_SPIN(xb_ld(&bar[XB_XGEN(b.x)]) == gen, bar);
            __builtin_amdgcn_fence(__ATOMIC_ACQUIRE, "agent");
            asm volatile("s_waitcnt vmcnt(0)" ::: "memory");
        }
    }
    __syncthreads();
}

DI void ctx_splitk_phase(unsigned char* lds, const u16* A, int lda, const u16* Bt, int ldb, int K, float* part) {
    const int kq = K >> 2;
    const int G = gridDim.x;
    for (int t = G - 1 - (int)blockIdx.x; t < 128; t += G) {
        const int ks = t & 3, n = (t >> 2) & 7, mt = t >> 5;
        EpiPartial e{part + (size_t)ks * MCTX * D};
        gemm_tile(lds, A + ks * kq, lda, Bt + ks * kq, ldb, kq, MLAT + 128 * mt, n * 128, e);
    }
}

#ifndef REP_G
#define REP_G 1
#endif
#ifndef REP_M
#define REP_M 1
#endif
#ifndef REP_C
#define REP_C 1
#endif
__global__ void __launch_bounds__(256, 2) mega_fwd(Params p) {
    extern __shared__ __attribute__((aligned(16))) unsigned char lds[];
    __shared__ uint4 xb_words;
    cg::grid_group grid = cg::this_grid();
    const int G = gridDim.x;
    if (threadIdx.x == 0) xb_words = make_uint4(0u, 0u, 0u, 0u);
    __syncthreads();
    const XcdBarrier xb = xcd_barrier_post((unsigned*)(p.ws + OFF_BAR), (volatile LAS unsigned*)&xb_words);
    prologue_phase(lds, p);
    if (p.ws == nullptr) grid.sync();
    xcd_barrier(xb);
    u16* wb = (u16*)(p.ws + OFF_WB);
    u16* xn = (u16*)(p.ws + OFF_XN);
    u16* proj = (u16*)(p.ws + OFF_PROJ);
    u16* cat = (u16*)(p.ws + OFF_CAT);
    u16* hb = (u16*)(p.ws + OFF_PROJ);
    float* xc = (float*)(p.ws + OFF_XC);
    const float* mod = (const float*)(p.ws + OFF_MOD);
#pragma unroll 1
    for (int l = 0; l < DEPTH; ++l) {
        const u16* wl = wb + (size_t)l * WL_SIZE;
        const bool last = l == DEPTH - 1;
        norm_phase(p, l, 0);
        xcd_barrier(xb);
        for (int rep = 0; rep < REP_G; ++rep) {
        { EpiProj e{proj, (const float*)(p.ws + OFF_ROPE), (const float*)(p.ws + OFF_ROPE) + 4096}; gemm_phase4(lds, xn, D, wl + WL_IN, D, D, MROWS / 256, NINP / 128, e); }
        xcd_barrier(xb);
        }
        for (int rep = 0; rep < REP_M; ++rep) {
            if (rep) xcd_barrier(xb);
            const int NA = 2048 + (last ? 0 : 32), NGA = 8 * 2 * NCH, NCV = (last ? MLAT : MROWS) / 32;
            for (int u = blockIdx.x; u < NA + NGA + NCV; u += G) {
                if (u < NA) attn_unit(lds, p, l, u);
                else if (u < NA + NGA) gla_passA_unit(lds, p, l, u - NA);
                else conv_unit(p, l, u - NA - NGA);
            }
        }
        xcd_barrier(xb);
        gla_scan_phase(p);
        if (!last) weights_phase(lds, p, l + 1, (16 * 4096 / 256) % G);
        xcd_barrier(xb);
        for (int rep = 0; rep < REP_C; ++rep) {
        for (int u = blockIdx.x; u < 4 * 2 * NCH; u += G) gla_passC_unit(lds, p, l, u);
        xcd_barrier(xb);
        }
        {
            EpiResid e{l == 0 ? p.x : p.out, l == 0 ? p.ctx : xc, p.out, xc, mod + (size_t)l * 3 * 6 * D + 2 * D};
            gemm_phase4(lds, cat, D, wl + WL_OUT, D, D, MLAT / 256, D / 128, e);
            if (!last) ctx_splitk_phase(lds, cat, D, wl + WL_OUT, D, D, (float*)(p.ws + OFF_PART));
        }
        xcd_barrier(xb);
        norm_phase(p, l, 1);
        xcd_barrier(xb);
        for (int rep = 0; rep < REP_G; ++rep) {
        { EpiSwiglu e{hb}; gemm_phase4(lds, xn, D, wl + WL_UP, D, D, (last ? MLAT : MROWS) / 256, 2 * DFF / 128, e); }
        xcd_barrier(xb);
        }
        {
            EpiResid e{p.out, xc, p.out, xc, mod + (size_t)l * 3 * 6 * D + 5 * D};
            gemm_phase4(lds, hb, DFF, wl + WL_DOWN, DFF, DFF, MLAT / 256, D / 128, e);
            if (!last) ctx_splitk_phase(lds, hb, DFF, wl + WL_DOWN, DFF, DFF, (float*)(p.ws + OFF_PART));
        }
        xcd_barrier(xb);
    }
    final_norm_phase(p);
}

extern "C" void kernel_launch(void* const* d_in, const int* in_sizes, int n_in, void* d_out, int out_size, void* d_ws, size_t ws_size, hipStream_t stream) {
    static int grid_blocks = 0;
    if (!grid_blocks) {
        if (ws_size < WS_END) { fprintf(stderr, "kernel_launch: workspace too small: %zu < %zu\n", ws_size, (size_t)WS_END); grid_blocks = -1; return; }
        int dev = 0, cus = 0, per_cu = 0;
        hipGetDevice(&dev);
        hipDeviceGetAttribute(&cus, hipDeviceAttributeMultiprocessorCount, dev);
        if (hipFuncSetAttribute((const void*)mega_fwd, hipFuncAttributeMaxDynamicSharedMemorySize, LDS_BYTES) != hipSuccess) fprintf(stderr, "kernel_launch: hipFuncSetAttribute failed\n");
        hipOccupancyMaxActiveBlocksPerMultiprocessor(&per_cu, (const void*)mega_fwd, 256, LDS_BYTES);
        if (per_cu < 1) per_cu = 1;
        if (per_cu > 2) per_cu = 2;
        grid_blocks = cus * per_cu;
        fprintf(stderr, "kernel_launch: cus %d per_cu %d grid %d\n", cus, per_cu, grid_blocks);
    }
    if (grid_blocks < 0) return;
    Params p{};
    p.x = (const float*)d_in[0]; p.c = (const float*)d_in[1]; p.ctx = (const float*)d_in[2]; p.c_ctx = (const float*)d_in[3];
    p.w_mod = (const float*)d_in[4]; p.b_mod = (const float*)d_in[5]; p.g1 = (const float*)d_in[6]; p.g2 = (const float*)d_in[7];
    p.w_in = (const float*)d_in[8]; p.conv_w = (const float*)d_in[9]; p.sink = (const float*)d_in[10]; p.gate_w = (const float*)d_in[11];
    p.gate_b = (const float*)d_in[12]; p.gnorm = (const float*)d_in[13]; p.w_out = (const float*)d_in[14]; p.w_up = (const float*)d_in[15];
    p.w_down = (const float*)d_in[16]; p.gfinal = (const float*)d_in[17];
    p.out = (float*)d_out; p.ws = (unsigned char*)d_ws;
    (void)hipMemsetAsync((unsigned char*)d_ws + OFF_BAR, 0, XCD_BAR_WORDS * 4, stream);
    void* args[] = {&p};
    hipError_t e = hipLaunchCooperativeKernel((const void*)mega_fwd, dim3(grid_blocks), dim3(256), args, LDS_BYTES, stream);
    if (e != hipSuccess) fprintf(stderr, "cooperative launch failed: %s (grid %d)\n", hipGetErrorString(e), grid_blocks);
}
```

```cpp
#include <hip/hip_runtime.h>
#include <hip/hip_cooperative_groups.h>
#include <cstdio>
#include <cstdint>
namespace cg = cooperative_groups;

#define DI __device__ __forceinline__
#define LAS __attribute__((address_space(3)))
typedef unsigned short u16;
typedef short bf16x8 __attribute__((ext_vector_type(8)));
typedef float f32x16 __attribute__((ext_vector_type(16)));
typedef float f32x4 __attribute__((ext_vector_type(4)));
typedef unsigned u32x4 __attribute__((ext_vector_type(4)));
typedef unsigned u32x2 __attribute__((ext_vector_type(2)));

constexpr int D = 1024, NB = 2, SEQ = 16384, CTX = 256, DEPTH = 4;
constexpr int NIN = 2592, NINP = 2688, DFF = 2816;
constexpr int MLAT = NB * SEQ, MCTX = NB * CTX, MROWS = MLAT + MCTX;
constexpr int C_CX = 0, C_CB = 256, C_CC = 512, C_Q = 768, C_K = 1280, C_V = 1408, C_GQ = 1536, C_GK = 1792, C_GV = 2048, C_GG = 2304, C_LR = 2560;
constexpr int NCH = 260;
constexpr float EPS = 1e-6f;
constexpr int XCD_BAR_WORDS_C = 3456;
constexpr float LOG2E = 1.4426950408889634f;

constexpr size_t WL_IN = 0, WL_OUT = (size_t)NINP * D, WL_UP = WL_OUT + (size_t)D * D, WL_DOWN = WL_UP + (size_t)2 * DFF * D, WL_SIZE = WL_DOWN + (size_t)D * DFF;
constexpr size_t OFF_WB = 0;
constexpr size_t OFF_XN = OFF_WB + WL_SIZE * DEPTH * 2;
constexpr size_t OFF_PROJ = OFF_XN + (size_t)MROWS * D * 2;
constexpr size_t OFF_CAT = OFF_PROJ + (size_t)MROWS * NIN * 2;
constexpr size_t OFF_XC = OFF_CAT + (size_t)MROWS * D * 2;
constexpr size_t OFF_MOD = OFF_XC + (size_t)MCTX * D * 4;
constexpr size_t OFF_ROPE = OFF_MOD + (size_t)DEPTH * 3 * 6 * D * 4;
constexpr size_t OFF_GST = OFF_ROPE + 2 * 256 * 16 * 4;
constexpr size_t OFF_GD = OFF_GST + (size_t)16 * NCH * 4096 * 4;
constexpr size_t OFF_PART = OFF_GD + (size_t)16 * NCH * 64 * 4;
constexpr size_t OFF_BAR = OFF_PART + (size_t)4 * MCTX * D * 4;
constexpr size_t WS_END = OFF_BAR + XCD_BAR_WORDS_C * 4;
static_assert(WS_END <= 536870912ull, "workspace too large");
static_assert((size_t)MROWS * DFF * 2 <= OFF_XC - OFF_PROJ, "h overlay does not fit");

struct Params {
    const float *x, *c, *ctx, *c_ctx, *w_mod, *b_mod, *g1, *g2, *w_in, *conv_w, *sink, *gate_w, *gate_b, *gnorm, *w_out, *w_up, *w_down, *gfinal;
    float* out; unsigned char* ws;
};

constexpr int LROW = 72;
constexpr int TILE_B = 128 * LROW * 2;
constexpr int T64_B = 64 * LROW * 2;
constexpr int LDS_BYTES = 4 * TILE_B;

typedef __bf16 bf16x2_t __attribute__((ext_vector_type(2)));
typedef float f32x2_t __attribute__((ext_vector_type(2)));
DI unsigned pk2(float lo, float hi) { f32x2_t v = {lo, hi}; bf16x2_t r = __builtin_convertvector(v, bf16x2_t); return __builtin_bit_cast(unsigned, r); }
DI u16 f2bf(float x) { return (u16)(pk2(x, 0.f) & 0xffffu); }
DI float bflo(unsigned w) { return __uint_as_float(w << 16); }
DI float bfhi(unsigned w) { return __uint_as_float(w & 0xffff0000u); }
DI float bf2f(u16 v) { return __uint_as_float(((unsigned)v) << 16); }
DI void unpack8(u32x4 v, float (&f)[8]) { f[0] = bflo(v.x); f[1] = bfhi(v.x); f[2] = bflo(v.y); f[3] = bfhi(v.y); f[4] = bflo(v.z); f[5] = bfhi(v.z); f[6] = bflo(v.w); f[7] = bfhi(v.w); }
DI u32x4 pack8(const float (&f)[8]) { u32x4 v; v.x = pk2(f[0], f[1]); v.y = pk2(f[2], f[3]); v.z = pk2(f[4], f[5]); v.w = pk2(f[6], f[7]); return v; }
DI int otid() { int t = threadIdx.x; asm volatile("" : "+v"(t)); return t; }
DI int pi32(int r) { return (r & 0x13) | ((r & 4) << 1) | ((r & 8) >> 1); }
DI int crow(int i, int h) { return (i & 3) + 8 * (i >> 2) + 4 * h; }
DI float wave_sum(float v) {
#pragma unroll
    for (int o = 1; o < 64; o <<= 1) v += __shfl_xor(v, o);
    return v;
}
DI float siluf(float a) { return a * __builtin_amdgcn_rcpf(1.f + __expf(-a)); }
#define MFMA32(a, b, c) __builtin_amdgcn_mfma_f32_32x32x16_bf16((a), (b), (c), 0, 0, 0)
DI f32x16 zero16() { f32x16 z;
#pragma unroll
    for (int i = 0; i < 16; ++i) z[i] = 0.f; return z; }

DI int up_dest(int n) { return n < DFF ? ((n >> 5) * 64 + (n & 31)) : ((((n - DFF) >> 5) * 64) + 32 + ((n - DFF) & 31)); }

template <int MODE>
DI void transpose_item(unsigned char* lds, const float* __restrict__ W, int K, int N, u16* __restrict__ WT, int kb, int nb) {
    float* tile = (float*)lds;
    const int tid = otid(), k0 = kb * 64, n0 = nb * 64;
    __syncthreads();
    {
        const int n = tid & 63, kq = tid >> 6;
#pragma unroll 4
        for (int i = 0; i < 16; ++i) { const int k = kq + 4 * i; tile[k * 65 + n] = (n0 + n < N) ? W[(size_t)(k0 + k) * N + n0 + n] : 0.f; }
    }
    __syncthreads();
    {
        const int ch = tid & 7;
#pragma unroll
        for (int j = 0; j < 2; ++j) {
            const int nn = (tid >> 3) + 32 * j;
            float f[8];
#pragma unroll
            for (int q = 0; q < 8; ++q) f[q] = tile[(8 * ch + q) * 65 + nn];
            const int dest = MODE == 1 ? up_dest(n0 + nn) : (n0 + nn);
            *(u32x4*)(WT + (size_t)dest * K + k0 + 8 * ch) = pack8(f);
        }
    }
}

DI void weights_phase(unsigned char* lds, const Params& p, int lw, int first_blk) {
    u16* wb = (u16*)(p.ws + OFF_WB);
    constexpr int I_IN = 16 * (NINP / 64), I_OUT = 16 * 16, I_UP = 16 * (2 * DFF / 64), I_DOWN = (DFF / 64) * 16, I_L = I_IN + I_OUT + I_UP + I_DOWN;
    const int G = gridDim.x;
    int me = (int)blockIdx.x - first_blk; if (me < 0) me += G;
    for (int it = me; it < I_L; it += G) {
        const int l = lw; int r = it;
        u16* wl = wb + (size_t)l * WL_SIZE;
        if (r < I_IN) { transpose_item<0>(lds, p.w_in + (size_t)l * D * NIN, D, NIN, wl + WL_IN, r / (NINP / 64), r % (NINP / 64)); continue; } r -= I_IN;
        if (r < I_OUT) { transpose_item<0>(lds, p.w_out + (size_t)l * D * D, D, D, wl + WL_OUT, r / 16, r % 16); continue; } r -= I_OUT;
        if (r < I_UP) { transpose_item<1>(lds, p.w_up + (size_t)l * D * 2 * DFF, D, 2 * DFF, wl + WL_UP, r / (2 * DFF / 64), r % (2 * DFF / 64)); continue; } r -= I_UP;
        transpose_item<0>(lds, p.w_down + (size_t)l * DFF * D, DFF, D, wl + WL_DOWN, r / 16, r % 16);
    }
    __syncthreads();
}

DI void prologue_phase(unsigned char* lds, const Params& p) {
    const int tid = otid();
    weights_phase(lds, p, 0, 0);
    __syncthreads();
    float* sv = (float*)lds;
    float* red = sv + 3 * D;
    for (int i = tid; i < 3 * D; i += 256) { const int v = i >> 10, k = i & 1023; const float c = v < 2 ? p.c[v * D + k] : p.c_ctx[k]; sv[i] = siluf(c); }
    __syncthreads();
    float* mod = (float*)(p.ws + OFF_MOD);
    for (int it = blockIdx.x; it < DEPTH * 96; it += gridDim.x) {
        const int l = it / 96, n0 = (it % 96) * 64, n = tid & 63, kq = tid >> 6;
        const float* w = p.w_mod + (size_t)l * D * 6 * D + (size_t)(kq * 256) * 6 * D + n0 + n;
        float a0 = 0.f, a1 = 0.f, a2 = 0.f;
#pragma unroll 8
        for (int k = 0; k < 256; ++k) { const float wv = w[(size_t)k * 6 * D]; const int kk = kq * 256 + k; a0 += sv[kk] * wv; a1 += sv[D + kk] * wv; a2 += sv[2 * D + kk] * wv; }
        red[(kq * 3 + 0) * 64 + n] = a0; red[(kq * 3 + 1) * 64 + n] = a1; red[(kq * 3 + 2) * 64 + n] = a2;
        __syncthreads();
        if (tid < 192) { const int v = tid >> 6, nn = tid & 63; float s = p.b_mod[l * 6 * D + n0 + nn];
#pragma unroll
            for (int q = 0; q < 4; ++q) s += red[(q * 3 + v) * 64 + nn];
            mod[((size_t)l * 3 + v) * 6 * D + n0 + nn] = s; }
        __syncthreads();
    }
    {
        const f32x4* s4 = (const f32x4*)p.ctx; f32x4* d4 = (f32x4*)(p.ws + OFF_XC);
        for (int i = blockIdx.x * 256 + tid; i < MCTX * D / 4; i += gridDim.x * 256) d4[i] = s4[i];
    }
    {
        const int g = blockIdx.x * 256 + tid;
        if (g < 4096) {
            const int pos = g >> 4, i = g & 15;
            const float inv = exp2f(-(float)i * (13.287712379549449f / 16.f));
            const float ang = (float)pos * inv;
            const double a = (double)ang, k = rint(a * 0.15915494309189535), rr = a - k * 6.283185307179586;
            const float rf = (float)rr;
            float* rc = (float*)(p.ws + OFF_ROPE);
            rc[g] = __cosf(rf); rc[4096 + g] = __sinf(rf);
        }
    }
}

DI void norm_phase(const Params& p, int l, int which) {
    const int tid = otid(), lane = tid & 63, wave = tid >> 6;
    const float* lat = (l == 0 && which == 0) ? p.x : p.out;
    const float* cx = (const float*)(p.ws + OFF_XC);
    const float* g = (which == 0 ? p.g1 : p.g2) + l * D;
    const float* mod = (const float*)(p.ws + OFF_MOD) + (size_t)l * 3 * 6 * D;
    u16* xn = (u16*)(p.ws + OFF_XN);
    const int nrows = (l == DEPTH - 1 && which == 1) ? MLAT : MROWS;
    const bool fold = which == 1 || l > 0;
    const float* part = (const float*)(p.ws + OFF_PART);
    const float* fgate = (const float*)(p.ws + OFF_MOD) + (size_t)(which == 1 ? l : l - 1) * 3 * 6 * D + 2 * 6 * D + (which == 1 ? 2 * D : 5 * D);
    const int NW = gridDim.x * 4, gw = blockIdx.x * 4 + wave;
    {
        const int rpw = ((MLAT + NW - 1) / NW + 3) & ~3;
        const int rbeg = gw * rpw, rend = (rbeg + rpw) < MLAT ? (rbeg + rpw) : MLAT;
        int cur_var = -1;
        f32x4 ga[4], sb[4];
        for (int r0 = rbeg; r0 < rend; r0 += 4) {
            const int var = r0 < SEQ ? 0 : 1;
            if (var != cur_var) {
                cur_var = var;
                const float* sh = mod + var * 6 * D + (which == 0 ? 0 : 3 * D);
                const float* sc = sh + D;
#pragma unroll
                for (int j = 0; j < 4; ++j) {
                    const int col = j * 256 + lane * 4;
                    const f32x4 gg = *(const f32x4*)(g + col), s1 = *(const f32x4*)(sc + col);
                    ga[j].x = gg.x * (1.f + s1.x); ga[j].y = gg.y * (1.f + s1.y); ga[j].z = gg.z * (1.f + s1.z); ga[j].w = gg.w * (1.f + s1.w);
                    sb[j] = *(const f32x4*)(sh + col);
                }
            }
            f32x4 v[4][4]; float ss[4];
#pragma unroll
            for (int q = 0; q < 4; ++q) {
                const int row = (r0 + q) < rend ? (r0 + q) : (rend - 1);
#pragma unroll
                for (int j = 0; j < 4; ++j) v[q][j] = *(const f32x4*)(lat + (size_t)row * D + j * 256 + lane * 4);
            }
#pragma unroll
            for (int q = 0; q < 4; ++q) {
                ss[q] = 0.f;
#pragma unroll
                for (int j = 0; j < 4; ++j) ss[q] += v[q][j].x * v[q][j].x + v[q][j].y * v[q][j].y + v[q][j].z * v[q][j].z + v[q][j].w * v[q][j].w;
                ss[q] = wave_sum(ss[q]);
            }
#pragma unroll
            for (int q = 0; q < 4; ++q) {
                if (r0 + q >= rend) continue;
                const float rs = rsqrtf(ss[q] * (1.f / D) + EPS);
#pragma unroll
                for (int j = 0; j < 4; ++j) {
                    f32x4 o;
                    o.x = v[q][j].x * rs * ga[j].x + sb[j].x; o.y = v[q][j].y * rs * ga[j].y + sb[j].y;
                    o.z = v[q][j].z * rs * ga[j].z + sb[j].z; o.w = v[q][j].w * rs * ga[j].w + sb[j].w;
                    u32x2 w; w.x = pk2(o.x, o.y); w.y = pk2(o.z, o.w);
                    *(u32x2*)(xn + (size_t)(r0 + q) * D + j * 256 + lane * 4) = w;
                }
            }
        }
    }
    for (int row = MLAT + gw; row < nrows; row += NW) {
        const float* xr = cx + (size_t)(row - MLAT) * D;
        f32x4 v[4]; float ss = 0.f;
#pragma unroll
        for (int j = 0; j < 4; ++j) v[j] = *(const f32x4*)(xr + j * 256 + lane * 4);
        if (fold) {
            const float* pp = part + (size_t)(row - MLAT) * D;
            float* xw = (float*)(p.ws + OFF_XC) + (size_t)(row - MLAT) * D;
#pragma unroll
            for (int j = 0; j < 4; ++j) {
                const int col = j * 256 + lane * 4;
                const f32x4 gt = *(const f32x4*)(fgate + col);
                const f32x4 p0 = *(const f32x4*)(pp + col), p1 = *(const f32x4*)(pp + (size_t)MCTX * D + col), p2 = *(const f32x4*)(pp + (size_t)2 * MCTX * D + col), p3 = *(const f32x4*)(pp + (size_t)3 * MCTX * D + col);
                v[j].x += gt.x * ((p0.x + p1.x) + (p2.x + p3.x)); v[j].y += gt.y * ((p0.y + p1.y) + (p2.y + p3.y));
                v[j].z += gt.z * ((p0.z + p1.z) + (p2.z + p3.z)); v[j].w += gt.w * ((p0.w + p1.w) + (p2.w + p3.w));
                *(f32x4*)(xw + col) = v[j];
            }
        }
#pragma unroll
        for (int j = 0; j < 4; ++j) ss += v[j].x * v[j].x + v[j].y * v[j].y + v[j].z * v[j].z + v[j].w * v[j].w;
        const float rs = rsqrtf(wave_sum(ss) * (1.f / D) + EPS);
        const float* sh = mod + 2 * 6 * D + (which == 0 ? 0 : 3 * D);
        const float* sc = sh + D;
#pragma unroll
        for (int j = 0; j < 4; ++j) {
            const int col = j * 256 + lane * 4;
            const f32x4 gg = *(const f32x4*)(g + col), s1 = *(const f32x4*)(sc + col), s0 = *(const f32x4*)(sh + col);
            f32x4 o;
            o.x = v[j].x * rs * gg.x * (1.f + s1.x) + s0.x; o.y = v[j].y * rs * gg.y * (1.f + s1.y) + s0.y;
            o.z = v[j].z * rs * gg.z * (1.f + s1.z) + s0.z; o.w = v[j].w * rs * gg.w * (1.f + s1.w) + s0.w;
            u32x2 w; w.x = pk2(o.x, o.y); w.y = pk2(o.z, o.w);
            *(u32x2*)(xn + (size_t)row * D + col) = w;
        }
    }
}

DI void final_norm_phase(const Params& p) {
    const int tid = otid(), lane = tid & 63, wave = tid >> 6;
    const int W = gridDim.x * 4;
    const f32x4 gg0 = *(const f32x4*)(p.gfinal + lane * 4), gg1 = *(const f32x4*)(p.gfinal + 256 + lane * 4), gg2 = *(const f32x4*)(p.gfinal + 512 + lane * 4), gg3 = *(const f32x4*)(p.gfinal + 768 + lane * 4);
    const f32x4 gg[4] = {gg0, gg1, gg2, gg3};
    for (int row0 = blockIdx.x * 4 + wave; row0 < MLAT; row0 += 4 * W) {
        f32x4 v[4][4]; float ss[4];
#pragma unroll
        for (int q = 0; q < 4; ++q) {
            const int row = row0 + q * W;
            ss[q] = 0.f;
#pragma unroll
            for (int j = 0; j < 4; ++j) v[q][j] = row < MLAT ? *(const f32x4*)(p.out + (size_t)row * D + j * 256 + lane * 4) : (f32x4){0.f, 0.f, 0.f, 0.f};
        }
#pragma unroll
        for (int q = 0; q < 4; ++q) {
#pragma unroll
            for (int j = 0; j < 4; ++j) ss[q] += v[q][j].x * v[q][j].x + v[q][j].y * v[q][j].y + v[q][j].z * v[q][j].z + v[q][j].w * v[q][j].w;
            ss[q] = wave_sum(ss[q]);
        }
#pragma unroll
        for (int q = 0; q < 4; ++q) {
            const int row = row0 + q * W;
            if (row >= MLAT) continue;
            const float rs = rsqrtf(ss[q] * (1.f / D) + EPS);
#pragma unroll
            for (int j = 0; j < 4; ++j) {
                f32x4 o; o.x = v[q][j].x * rs * gg[j].x; o.y = v[q][j].y * rs * gg[j].y; o.z = v[q][j].z * rs * gg[j].z; o.w = v[q][j].w * rs * gg[j].w;
                *(f32x4*)(p.out + (size_t)row * D + j * 256 + lane * 4) = o;
            }
        }
    }
}

template <class Epi>
DI void gemm_tile(unsigned char* lds, const u16* __restrict__ A, int lda, const u16* __restrict__ Bt, int ldb, int K, int m0, int n0, const Epi& epi) {
    const int tid = otid(), lane = tid & 63, wave = tid >> 6, wm = wave >> 1, wn = wave & 1, r = lane & 31, h = lane >> 5;
    const u16* ga = A + (size_t)(m0 + (tid >> 3)) * lda + (tid & 7) * 8;
    const u16* gb = Bt + (size_t)(n0 + (tid >> 3)) * ldb + (tid & 7) * 8;
    const int soff = ((tid >> 3) * LROW + (tid & 7) * 8) * 2;
    const int aoff = ((64 * wm + r) * LROW + 8 * h) * 2, boff = TILE_B + ((64 * wn + pi32(r)) * LROW + 8 * h) * 2;
    u32x4 ra[4], rb[4];
    f32x16 acc[2][2];
#pragma unroll
    for (int a = 0; a < 2; ++a)
#pragma unroll
        for (int b = 0; b < 2; ++b) acc[a][b] = zero16();
    const int nk = K >> 6;
#pragma unroll
    for (int i = 0; i < 4; ++i) { ra[i] = *(const u32x4*)(ga + (size_t)(32 * i) * lda); rb[i] = *(const u32x4*)(gb + (size_t)(32 * i) * ldb); }
#pragma unroll
    for (int i = 0; i < 4; ++i) { *(u32x4*)(lds + soff + i * 32 * LROW * 2) = ra[i]; *(u32x4*)(lds + TILE_B + soff + i * 32 * LROW * 2) = rb[i]; }
    __syncthreads();
    for (int kt = 0; kt < nk; ++kt) {
        const bool more = kt + 1 < nk;
        if (more) {
            const int k0 = (kt + 1) * 64;
#pragma unroll
            for (int i = 0; i < 4; ++i) { ra[i] = *(const u32x4*)(ga + (size_t)(32 * i) * lda + k0); rb[i] = *(const u32x4*)(gb + (size_t)(32 * i) * ldb + k0); }
        }
        __builtin_amdgcn_sched_barrier(0);
        const unsigned char* st = lds + (kt & 1) * 2 * TILE_B;
#pragma unroll
        for (int s = 0; s < 4; ++s) {
            bf16x8 af[2], bfr[2];
#pragma unroll
            for (int mi = 0; mi < 2; ++mi) af[mi] = *(const bf16x8*)(st + aoff + mi * 32 * LROW * 2 + s * 32);
#pragma unroll
            for (int ni = 0; ni < 2; ++ni) bfr[ni] = *(const bf16x8*)(st + boff + ni * 32 * LROW * 2 + s * 32);
#pragma unroll
            for (int mi = 0; mi < 2; ++mi)
#pragma unroll
                for (int ni = 0; ni < 2; ++ni) acc[mi][ni] = MFMA32(bfr[ni], af[mi], acc[mi][ni]);
        }
        if (more) {
            unsigned char* sn = lds + ((kt + 1) & 1) * 2 * TILE_B;
#pragma unroll
            for (int i = 0; i < 4; ++i) { *(u32x4*)(sn + soff + i * 32 * LROW * 2) = ra[i]; *(u32x4*)(sn + TILE_B + soff + i * 32 * LROW * 2) = rb[i]; }
        }
        __syncthreads();
    }
    epi.template operator()<2>(acc, m0 + 64 * wm, n0 + 64 * wn, r, h);
}

template <class Epi>
DI void gemm_phase(unsigned char* lds, const u16* A, int lda, const u16* Bt, int ldb, int K, int mtiles, int ntiles, const Epi& epi) {
    const int G = gridDim.x;
    if ((G & 7) == 0) {
        const int xcd = blockIdx.x & 7, local = blockIdx.x >> 3, nlocal = G >> 3;
        const int nmx = (mtiles - xcd + 7) >> 3, total = nmx * ntiles;
        for (int lt = local; lt < total; lt += nlocal) { const int mj = lt / ntiles, n = lt % ntiles; gemm_tile(lds, A, lda, Bt, ldb, K, (xcd + 8 * mj) * 128, n * 128, epi); }
    } else {
        for (int t = blockIdx.x; t < mtiles * ntiles; t += G) gemm_tile(lds, A, lda, Bt, ldb, K, (t / ntiles) * 128, (t % ntiles) * 128, epi);
    }
}

constexpr int A4_B = 256 * LROW * 2, B4_B = 128 * LROW * 2, ST4_B = A4_B + B4_B;
static_assert(ST4_B <= LDS_BYTES, "tile4 lds");
template <class Epi>
DI void gemm_tile4(unsigned char* lds, const u16* __restrict__ A, int lda, const u16* __restrict__ Bt, int ldb, int K, int m0, int n0, const Epi& epi) {
    const int tid = otid(), lane = tid & 63, wave = tid >> 6, wm = wave >> 1, wn = wave & 1, r = lane & 31, h = lane >> 5;
    const u16* ga = A + (size_t)(m0 + (tid >> 3)) * lda + (tid & 7) * 8;
    const u16* gb = Bt + (size_t)(n0 + (tid >> 3)) * ldb + (tid & 7) * 8;
    const int soff = ((tid >> 3) * LROW + (tid & 7) * 8) * 2;
    const int aoff = ((128 * wm + r) * LROW + 8 * h) * 2, boff = A4_B + ((64 * wn + pi32(r)) * LROW + 8 * h) * 2;
    u32x4 ra[8], rb[4];
    f32x16 acc[4][2];
#pragma unroll
    for (int a = 0; a < 4; ++a)
#pragma unroll
        for (int b = 0; b < 2; ++b) acc[a][b] = zero16();
    const int nk = K >> 6;
#pragma unroll
    for (int i = 0; i < 8; ++i) ra[i] = *(const u32x4*)(ga + (size_t)(32 * i) * lda);
#pragma unroll
    for (int i = 0; i < 4; ++i) rb[i] = *(const u32x4*)(gb + (size_t)(32 * i) * ldb);
    for (int kt = 0; kt < nk; ++kt) {
        __syncthreads();
#pragma unroll
        for (int i = 0; i < 8; ++i) *(u32x4*)(lds + soff + i * 32 * LROW * 2) = ra[i];
#pragma unroll
        for (int i = 0; i < 4; ++i) *(u32x4*)(lds + A4_B + soff + i * 32 * LROW * 2) = rb[i];
        __syncthreads();
        {
            const int k0 = (kt + 1 < nk ? kt + 1 : kt) * 64;
#pragma unroll
            for (int i = 0; i < 8; ++i) ra[i] = *(const u32x4*)(ga + (size_t)(32 * i) * lda + k0);
#pragma unroll
            for (int i = 0; i < 4; ++i) rb[i] = *(const u32x4*)(gb + (size_t)(32 * i) * ldb + k0);
        }
        __builtin_amdgcn_sched_barrier(0);
#pragma unroll
        for (int s = 0; s < 4; ++s) {
            bf16x8 af[4], bfr[2];
#pragma unroll
            for (int mi = 0; mi < 4; ++mi) af[mi] = *(const bf16x8*)(lds + aoff + mi * 32 * LROW * 2 + s * 32);
#pragma unroll
            for (int ni = 0; ni < 2; ++ni) bfr[ni] = *(const bf16x8*)(lds + boff + ni * 32 * LROW * 2 + s * 32);
#pragma unroll
            for (int mi = 0; mi < 4; ++mi)
#pragma unroll
                for (int ni = 0; ni < 2; ++ni) acc[mi][ni] = MFMA32(bfr[ni], af[mi], acc[mi][ni]);
        }
    }
    epi.template operator()<4>(acc, m0 + 128 * wm, n0 + 64 * wn, r, h);
}


constexpr int G5_A = 256 * 64, G5_B = 128 * 64, G5_ST = G5_A + G5_B;
static_assert(3 * G5_ST <= LDS_BYTES, "tile5 lds");
template <class Epi>
DI void gemm_tile5(unsigned char* ldsg, const u16* __restrict__ A, int lda, const u16* __restrict__ Bt, int ldb, int K, int m0, int n0, const Epi& epi) {
    LAS unsigned char* lds = (LAS unsigned char*)ldsg;
    const int tid = otid(), lane = tid & 63, wave = __builtin_amdgcn_readfirstlane(tid >> 6), wm = wave >> 1, wn = wave & 1, r = lane & 31, h = lane >> 5;
    const int gl_row = lane >> 2, gl_c = (lane & 3) ^ ((lane >> 4) & 3);
    const u16* gA = A + (size_t)(m0 + 64 * wave + gl_row) * lda + gl_c * 8;
    const u16* gB = Bt + (size_t)(n0 + 32 * wave + gl_row) * ldb + gl_c * 8;
    const int ldsA = wave * 4096, ldsB = G5_A + wave * 2048;
    const int xa = (r >> 2) & 3, pr = pi32(r), xb = (pr >> 2) & 3;
    const int a0 = (128 * wm + r) * 64 + ((h ^ xa) << 4), a1 = (128 * wm + r) * 64 + (((2 + h) ^ xa) << 4);
    const int b0 = G5_A + (64 * wn + pr) * 64 + ((h ^ xb) << 4), b1 = G5_A + (64 * wn + pr) * 64 + (((2 + h) ^ xb) << 4);
    f32x16 acc[4][2];
#pragma unroll
    for (int a = 0; a < 4; ++a)
#pragma unroll
        for (int b = 0; b < 2; ++b) acc[a][b] = zero16();
    const int nk = K >> 5;
#define G5_ISSUE(so_, kt_) do { const int k0_ = ((kt_) < nk ? (kt_) : nk - 1) * 32; \
        _Pragma("unroll") for (int j = 0; j < 4; ++j) __builtin_amdgcn_global_load_lds((const unsigned*)(gA + (size_t)(16 * j) * lda + k0_), (LAS unsigned*)(lds + (so_) + ldsA + j * 1024), 16, 0, 0); \
        _Pragma("unroll") for (int j = 0; j < 2; ++j) __builtin_amdgcn_global_load_lds((const unsigned*)(gB + (size_t)(16 * j) * ldb + k0_), (LAS unsigned*)(lds + (so_) + ldsB + j * 1024), 16, 0, 0); } while (0)
    int st_cur = 0, st_nxt = G5_ST, st_wr = 2 * G5_ST;
    G5_ISSUE(st_cur, 0);
    G5_ISSUE(st_nxt, 1);
    asm volatile("s_waitcnt vmcnt(6)" ::: "memory");
    __builtin_amdgcn_s_barrier();
    asm volatile("" ::: "memory");
    for (int kt = 0; kt < nk; ++kt) {
        G5_ISSUE(st_wr, kt + 2);
        {
            bf16x8 af[2][4], bfr[2][2];
#pragma unroll
            for (int ni = 0; ni < 2; ++ni) { bfr[0][ni] = *(const LAS bf16x8*)(lds + st_cur + b0 + ni * 2048); }
#pragma unroll
            for (int mi = 0; mi < 4; ++mi) { af[0][mi] = *(const LAS bf16x8*)(lds + st_cur + a0 + mi * 2048); }
#pragma unroll
            for (int ni = 0; ni < 2; ++ni) { bfr[1][ni] = *(const LAS bf16x8*)(lds + st_cur + b1 + ni * 2048); }
#pragma unroll
            for (int mi = 0; mi < 4; ++mi) { af[1][mi] = *(const LAS bf16x8*)(lds + st_cur + a1 + mi * 2048); }
            __builtin_amdgcn_sched_barrier(0);
            __builtin_amdgcn_s_setprio(1);
#pragma unroll
            for (int s = 0; s < 2; ++s)
#pragma unroll
                for (int mi = 0; mi < 4; ++mi)
#pragma unroll
                    for (int ni = 0; ni < 2; ++ni) acc[mi][ni] = MFMA32(bfr[s][ni], af[s][mi], acc[mi][ni]);
            __builtin_amdgcn_s_setprio(0);
            __builtin_amdgcn_sched_barrier(0);
        }
        asm volatile("s_waitcnt vmcnt(6)" ::: "memory");
        __builtin_amdgcn_s_barrier();
        asm volatile("" ::: "memory");
        { const int t_ = st_cur; st_cur = st_nxt; st_nxt = st_wr; st_wr = t_; }
    }
    asm volatile("s_waitcnt vmcnt(0)" ::: "memory");
    __builtin_amdgcn_s_barrier();
    asm volatile("" ::: "memory");
#undef G5_ISSUE
    if constexpr (Epi::STAGED == 1) {
        epi.template staged<4>(acc, m0 + 128 * wm, n0 + 64 * wn, r, h, ldsg + wave * (32 * 68 * 4), lane);
        __builtin_amdgcn_s_barrier();
        asm volatile("" ::: "memory");
    } else if constexpr (Epi::STAGED == 2) {
        epi.template stage<4>(acc, wm, wn, m0, n0, r, h, ldsg);
        __syncthreads();
        epi.flush(m0, n0, tid, ldsg);
        __syncthreads();
    } else {
        epi.template operator()<4>(acc, m0 + 128 * wm, n0 + 64 * wn, r, h);
    }
}

template <int GW>
DI void tile_of(int lt, int nmx, int ntiles, int& mj, int& n) {
    const int gsz = nmx * GW, g = lt / gsz, rem = lt - g * gsz;
    const int w = (ntiles - GW * g) < GW ? (ntiles - GW * g) : GW;
    mj = rem / w; n = GW * g + rem - mj * w;
}
template <class Epi>
DI void gemm_phase4(unsigned char* lds, const u16* A, int lda, const u16* Bt, int ldb, int K, int mtiles, int ntiles, const Epi& epi) {
    const int G = gridDim.x;
    if ((G & 7) == 0) {
        const int xcd = blockIdx.x & 7, local = blockIdx.x >> 3, nlocal = G >> 3;
        const int nmx = (mtiles - xcd + 7) >> 3, total = nmx * ntiles;
        for (int lt = local; lt < total; lt += nlocal) { int mj, n; tile_of<8>(lt, nmx, ntiles, mj, n); gemm_tile5(lds, A, lda, Bt, ldb, K, (xcd + 8 * mj) * 256, n * 128, epi); }
    } else {
        for (int t = blockIdx.x; t < mtiles * ntiles; t += G) gemm_tile5(lds, A, lda, Bt, ldb, K, (t / ntiles) * 256, (t % ntiles) * 128, epi);
    }
}

struct EpiProj {
    static constexpr int STAGED = 2;
    static constexpr int ROWB = 272;
    u16* proj; const float* ropec; const float* ropes;
    template <int MI> DI void stage(const f32x16 (&acc)[MI][2], int wm, int wn, int m0, int n0, int r, int h, unsigned char* lds) const {
        const int nb = n0 + 64 * wn;
        const bool isq = nb >= C_Q && nb < C_K, isk = nb >= C_K && nb < C_V;
        const float qs = isq ? 0.125f * LOG2E : 1.f;
#pragma unroll
        for (int mi = 0; mi < MI; ++mi) {
            const int rl = 128 * wm + 32 * mi + r, row = m0 + rl;
            const bool rope = (isq || isk) && row < MLAT;
            const int t = row & (SEQ - 1);
#pragma unroll
            for (int ni = 0; ni < 2; ++ni) {
                float lo[8], hi[8];
#pragma unroll
                for (int j = 0; j < 8; ++j) { lo[j] = acc[mi][ni][j]; hi[j] = acc[mi][ni][8 + j]; }
                if (rope) {
                    const int pos = ni == 0 ? (t >> 6) : (t & 63);
                    const float* cp = ropec + pos * 16 + 8 * h; const float* sp = ropes + pos * 16 + 8 * h;
#pragma unroll
                    for (int j = 0; j < 8; ++j) { const float c = cp[j], s = sp[j], x1 = lo[j], x2 = hi[j]; lo[j] = x1 * c - x2 * s; hi[j] = x2 * c + x1 * s; }
                }
                if (isq) {
#pragma unroll
                    for (int j = 0; j < 8; ++j) { lo[j] *= qs; hi[j] *= qs; }
                }
                unsigned char* d = lds + rl * ROWB + (64 * wn + 32 * ni + 8 * h) * 2;
                *(u32x4*)d = pack8(lo); *(u32x4*)(d + 32) = pack8(hi);
            }
        }
    }
    DI void flush(int m0, int n0, int tid, const unsigned char* lds) const {
#pragma unroll
        for (int k = 0; k < 16; ++k) {
            const int id = tid + 256 * k, row = id >> 4, c = id & 15;
            const u32x4 v = *(const u32x4*)(lds + row * ROWB + c * 16);
            if (n0 + 8 * c < NIN) *(u32x4*)(proj + (size_t)(m0 + row) * NIN + n0 + 8 * c) = v;
        }
    }
    template <int MI> DI void operator()(const f32x16 (&acc)[MI][2], int mb, int nb, int r, int h) const {
        const bool isq = nb >= C_Q && nb < C_K, isk = nb >= C_K && nb < C_V;
        const float qs = isq ? 0.125f * LOG2E : 1.f;
#pragma unroll
        for (int mi = 0; mi < MI; ++mi) {
            const int row = mb + 32 * mi + r;
            u16* rp = proj + (size_t)row * NIN;
            const bool rope = (isq || isk) && row < MLAT;
            const int t = row & (SEQ - 1);
#pragma unroll
            for (int ni = 0; ni < 2; ++ni) {
                float lo[8], hi[8];
#pragma unroll
                for (int j = 0; j < 8; ++j) { lo[j] = acc[mi][ni][j]; hi[j] = acc[mi][ni][8 + j]; }
                if (rope) {
                    const int pos = ni == 0 ? (t >> 6) : (t & 63);
                    const float* cp = ropec + pos * 16 + 8 * h; const float* sp = ropes + pos * 16 + 8 * h;
#pragma unroll
                    for (int j = 0; j < 8; ++j) { const float c = cp[j], s = sp[j], x1 = lo[j], x2 = hi[j]; lo[j] = x1 * c - x2 * s; hi[j] = x2 * c + x1 * s; }
                }
                if (isq) {
#pragma unroll
                    for (int j = 0; j < 8; ++j) { lo[j] *= qs; hi[j] *= qs; }
                }
                const int n = nb + 32 * ni + 8 * h;
                if (n < NIN) *(u32x4*)(rp + n) = pack8(lo);
                if (n + 16 < NIN) *(u32x4*)(rp + n + 16) = pack8(hi);
            }
        }
    }
};
struct EpiResid {
    static constexpr int STAGED = 1;
    const float* src_lat; const float* src_ctx; float* dst_lat; float* dst_ctx; const float* gate;
    template <int MI> DI void staged(const f32x16 (&acc)[MI][2], int mb, int nb, int r, int h, unsigned char* wl, int lane) const {
        const int var = mb < SEQ ? 0 : (mb < MLAT ? 1 : 2);
        const int rr = lane >> 4, c4 = (lane & 15) * 4;
        const f32x4 gt = *(const f32x4*)(gate + var * 6 * D + nb + c4);
        float* W = (float*)wl;
        f32x4 xs[2][8];
#pragma unroll
        for (int s = 0; s < 2; ++s)
#pragma unroll
            for (int it = 0; it < 8; ++it) {
                const int row = mb + 32 * s + 4 * it + rr;
                const float* sp = row < MLAT ? src_lat + (size_t)row * D : src_ctx + (size_t)(row - MLAT) * D;
                xs[s][it] = *(const f32x4*)(sp + nb + c4);
            }
#pragma unroll
        for (int mi = 0; mi < MI; ++mi) {
#pragma unroll
            for (int ni = 0; ni < 2; ++ni)
#pragma unroll
                for (int g = 0; g < 2; ++g) {
                    float* d = W + r * 68 + 32 * ni + 16 * g + 8 * h;
                    f32x4 v0, v1;
                    v0.x = acc[mi][ni][8 * g]; v0.y = acc[mi][ni][8 * g + 1]; v0.z = acc[mi][ni][8 * g + 2]; v0.w = acc[mi][ni][8 * g + 3];
                    v1.x = acc[mi][ni][8 * g + 4]; v1.y = acc[mi][ni][8 * g + 5]; v1.z = acc[mi][ni][8 * g + 6]; v1.w = acc[mi][ni][8 * g + 7];
                    *(f32x4*)d = v0; *(f32x4*)(d + 4) = v1;
                }
            asm volatile("s_waitcnt lgkmcnt(0)" ::: "memory");
#pragma unroll
            for (int it = 0; it < 8; ++it) {
                const int rl = 4 * it + rr, row = mb + 32 * mi + rl;
                const f32x4 a = *(const f32x4*)(W + rl * 68 + c4);
                float* dp = row < MLAT ? dst_lat + (size_t)row * D : dst_ctx + (size_t)(row - MLAT) * D;
                const f32x4 s = xs[mi & 1][it];
                f32x4 o; o.x = s.x + gt.x * a.x; o.y = s.y + gt.y * a.y; o.z = s.z + gt.z * a.z; o.w = s.w + gt.w * a.w;
                *(f32x4*)(dp + nb + c4) = o;
            }
            asm volatile("s_waitcnt lgkmcnt(0)" ::: "memory");
            if (mi + 2 < MI) {
#pragma unroll
                for (int it = 0; it < 8; ++it) {
                    const int row = mb + 32 * (mi + 2) + 4 * it + rr;
                    const float* sp = row < MLAT ? src_lat + (size_t)row * D : src_ctx + (size_t)(row - MLAT) * D;
                    xs[mi & 1][it] = *(const f32x4*)(sp + nb + c4);
                }
            }
        }
    }
    template <int MI> DI void operator()(const f32x16 (&acc)[MI][2], int mb, int nb, int r, int h) const {
        const int var = mb < SEQ ? 0 : (mb < MLAT ? 1 : 2);
        const float* gv = gate + var * 6 * D;
#pragma unroll
        for (int mi = 0; mi < MI; ++mi) {
            const int row = mb + 32 * mi + r;
            const float* sp = row < MLAT ? src_lat + (size_t)row * D : src_ctx + (size_t)(row - MLAT) * D;
            float* dp = row < MLAT ? dst_lat + (size_t)row * D : dst_ctx + (size_t)(row - MLAT) * D;
#pragma unroll
            for (int ni = 0; ni < 2; ++ni)
#pragma unroll
                for (int g = 0; g < 2; ++g) {
                    const int n = nb + 32 * ni + 16 * g + 8 * h;
#pragma unroll
                    for (int q = 0; q < 2; ++q) {
                        const f32x4 s = *(const f32x4*)(sp + n + 4 * q), gt = *(const f32x4*)(gv + n + 4 * q);
                        f32x4 o; o.x = s.x + gt.x * acc[mi][ni][8 * g + 4 * q]; o.y = s.y + gt.y * acc[mi][ni][8 * g + 4 * q + 1];
                        o.z = s.z + gt.z * acc[mi][ni][8 * g + 4 * q + 2]; o.w = s.w + gt.w * acc[mi][ni][8 * g + 4 * q + 3];
                        *(f32x4*)(dp + n + 4 * q) = o;
                    }
                }
        }
    }
};
struct EpiPartial {
    float* part;
    template <int MI> DI void operator()(const f32x16 (&acc)[MI][2], int mb, int nb, int r, int h) const {
#pragma unroll
        for (int mi = 0; mi < MI; ++mi) {
            float* dp = part + (size_t)(mb + 32 * mi + r - MLAT) * D;
#pragma unroll
            for (int ni = 0; ni < 2; ++ni)
#pragma unroll
                for (int g = 0; g < 2; ++g) {
                    const int n = nb + 32 * ni + 16 * g + 8 * h;
                    f32x4 v0, v1;
                    v0.x = acc[mi][ni][8 * g]; v0.y = acc[mi][ni][8 * g + 1]; v0.z = acc[mi][ni][8 * g + 2]; v0.w = acc[mi][ni][8 * g + 3];
                    v1.x = acc[mi][ni][8 * g + 4]; v1.y = acc[mi][ni][8 * g + 5]; v1.z = acc[mi][ni][8 * g + 6]; v1.w = acc[mi][ni][8 * g + 7];
                    *(f32x4*)(dp + n) = v0; *(f32x4*)(dp + n + 4) = v1;
                }
        }
    }
};
struct EpiSwiglu {
    static constexpr int STAGED = 2;
    static constexpr int ROWB = 144;
    u16* hb;
    template <int MI> DI void stage(const f32x16 (&acc)[MI][2], int wm, int wn, int m0, int n0, int r, int h, unsigned char* lds) const {
#pragma unroll
        for (int mi = 0; mi < MI; ++mi) {
            const int rl = 128 * wm + 32 * mi + r;
#pragma unroll
            for (int g = 0; g < 2; ++g) {
                float f[8];
#pragma unroll
                for (int j = 0; j < 8; ++j) f[j] = siluf(acc[mi][0][8 * g + j]) * acc[mi][1][8 * g + j];
                *(u32x4*)(lds + rl * ROWB + (32 * wn + 16 * g + 8 * h) * 2) = pack8(f);
            }
        }
    }
    DI void flush(int m0, int n0, int tid, const unsigned char* lds) const {
#pragma unroll
        for (int k = 0; k < 8; ++k) {
            const int id = tid + 256 * k, row = id >> 3, c = id & 7;
            *(u32x4*)(hb + (size_t)(m0 + row) * DFF + (n0 >> 1) + 8 * c) = *(const u32x4*)(lds + row * ROWB + c * 16);
        }
    }
    template <int MI> DI void operator()(const f32x16 (&acc)[MI][2], int mb, int nb, int r, int h) const {
#pragma unroll
        for (int mi = 0; mi < MI; ++mi) {
            u16* rp = hb + (size_t)(mb + 32 * mi + r) * DFF + (nb >> 1);
#pragma unroll
            for (int g = 0; g < 2; ++g) {
                float f[8];
#pragma unroll
                for (int j = 0; j < 8; ++j) f[j] = siluf(acc[mi][0][8 * g + j]) * acc[mi][1][8 * g + j];
                *(u32x4*)(rp + 16 * g + 8 * h) = pack8(f);
            }
        }
    }
};

DI void attn_unit(unsigned char* lds, const Params& p, int l, int u) {
    const u16* proj = (const u16*)(p.ws + OFF_PROJ);
    u16* cat = (u16*)(p.ws + OFF_CAT);
    const float* ropec = (const float*)(p.ws + OFF_ROPE);
    const float* ropes = ropec + 4096;
    u16* Ks = (u16*)lds; u16* Vt = (u16*)(lds + T64_B);
    const int tid = otid(), lane = tid & 63, wave = tid >> 6, r = lane & 31, h = lane >> 5;
    const bool isctx = u >= 2048;
    int b, hd, qb;
    if (!isctx) { qb = u & 127; hd = (u >> 7) & 7; b = u >> 10; } else { const int cu = u - 2048; qb = cu & 1; hd = (cu >> 1) & 7; b = cu >> 4; }
    const int kvh = hd >> 2;
    const int q0 = 128 * qb + 32 * wave;
    const size_t qrow = (size_t)(isctx ? MLAT + b * CTX : b * SEQ) + q0 + r;
    bf16x8 qf[4];
#pragma unroll
    for (int s = 0; s < 4; ++s) qf[s] = __builtin_bit_cast(bf16x8, *(const u32x4*)(proj + qrow * NIN + C_Q + hd * 64 + 16 * s + 8 * h));
    float m = p.sink[l * 8 + hd] * LOG2E;
    float lsum = (h == 0) ? 1.f : 0.f;
    f32x16 O0 = zero16(), O1 = zero16();
    const int ntiles = isctx ? 4 : 10;
    for (int tile = 0; tile < ntiles; ++tile) {
        const bool local = tile >= 4;
        int tk0 = 0; size_t krow0;
        if (!local) krow0 = (size_t)MLAT + b * CTX + 64 * tile;
        else { tk0 = 128 * qb - 128 + 64 * (tile - 4); if (tk0 < 0 || tk0 >= SEQ) continue; krow0 = (size_t)b * SEQ + tk0; }
        __syncthreads();
        {
            const int key = tid >> 2, part = tid & 3, half = part >> 1, sub = part & 1;
            const u16* kp = proj + (krow0 + key) * NIN + C_K + kvh * 64 + 32 * half + 8 * sub;
            u32x4 w1 = *(const u32x4*)kp, w2 = *(const u32x4*)(kp + 16);
            *(u32x4*)(Ks + key * LROW + 32 * half + 8 * sub) = w1;
            *(u32x4*)(Ks + key * LROW + 32 * half + 16 + 8 * sub) = w2;
        }
        {
            const int key = tid & 63, dc = tid >> 6;
            const u16* vp = proj + (krow0 + key) * NIN + C_V + kvh * 64 + 16 * dc;
            const u32x4 v0 = *(const u32x4*)vp, v1 = *(const u32x4*)(vp + 8);
            const unsigned wv[8] = {v0.x, v0.y, v0.z, v0.w, v1.x, v1.y, v1.z, v1.w};
#pragma unroll
            for (int i = 0; i < 8; ++i) { Vt[(16 * dc + 2 * i) * LROW + key] = (u16)(wv[i] & 0xffffu); Vt[(16 * dc + 2 * i + 1) * LROW + key] = (u16)(wv[i] >> 16); }
        }
        __syncthreads();
        if (local && (tk0 + 63 < q0 - 128 || tk0 > q0 + 31 + 128)) continue;
        const bool needmask = local && !(tk0 >= q0 + 31 - 128 && tk0 + 63 <= q0 + 128);
#pragma unroll
        for (int sub = 0; sub < 2; ++sub) {
            f32x16 s0 = zero16();
#pragma unroll
            for (int s = 0; s < 4; ++s) {
                const bf16x8 ka0 = *(const bf16x8*)(Ks + (32 * sub + pi32(r)) * LROW + 16 * s + 8 * h);
                s0 = MFMA32(ka0, qf[s], s0);
            }
            if (needmask) {
                const int tq = q0 + r;
#pragma unroll
                for (int i = 0; i < 16; ++i) {
                    const int tk = tk0 + 32 * sub + 16 * (i >> 3) + 8 * h + (i & 7);
                    const int d0 = tq - tk;
                    if (d0 > 128 || d0 < -128) s0[i] = -INFINITY;
                }
            }
            float mx = s0[0];
#pragma unroll
            for (int i = 1; i < 16; ++i) mx = fmaxf(mx, s0[i]);
            mx = fmaxf(mx, __shfl_xor(mx, 32));
            const float mn = fmaxf(m, mx);
            const float alpha = __builtin_amdgcn_exp2f(m - mn);
            m = mn;
            float ps = 0.f;
#pragma unroll
            for (int i = 0; i < 16; ++i) { s0[i] = __builtin_amdgcn_exp2f(s0[i] - mn); ps += s0[i]; }
            lsum = lsum * alpha + ps;
            if (__builtin_amdgcn_ballot_w64(alpha != 1.f) != 0ull) {
#pragma unroll
                for (int i = 0; i < 16; ++i) { O0[i] *= alpha; O1[i] *= alpha; }
            }
            bf16x8 pf[2];
            {
                u32x4 w;
                w.x = pk2(s0[0], s0[1]); w.y = pk2(s0[2], s0[3]); w.z = pk2(s0[4], s0[5]); w.w = pk2(s0[6], s0[7]); pf[0] = __builtin_bit_cast(bf16x8, w);
                w.x = pk2(s0[8], s0[9]); w.y = pk2(s0[10], s0[11]); w.z = pk2(s0[12], s0[13]); w.w = pk2(s0[14], s0[15]); pf[1] = __builtin_bit_cast(bf16x8, w);
            }
#pragma unroll
            for (int ks = 0; ks < 2; ++ks) {
                const bf16x8 va0 = *(const bf16x8*)(Vt + r * LROW + 32 * sub + 16 * ks + 8 * h);
                const bf16x8 va1 = *(const bf16x8*)(Vt + (32 + r) * LROW + 32 * sub + 16 * ks + 8 * h);
                O0 = MFMA32(va0, pf[ks], O0); O1 = MFMA32(va1, pf[ks], O1);
            }
        }
    }
    const float lt = lsum + __shfl_xor(lsum, 32);
    const float inv = 1.f / lt;
    {
        unsigned char* patch = lds + 20480 + wave * (32 * 144);
#pragma unroll
        for (int g4 = 0; g4 < 4; ++g4) {
            u32x2 w0, w1;
            w0.x = pk2(O0[4 * g4] * inv, O0[4 * g4 + 1] * inv); w0.y = pk2(O0[4 * g4 + 2] * inv, O0[4 * g4 + 3] * inv);
            w1.x = pk2(O1[4 * g4] * inv, O1[4 * g4 + 1] * inv); w1.y = pk2(O1[4 * g4 + 2] * inv, O1[4 * g4 + 3] * inv);
            *(u32x2*)(patch + r * 144 + (8 * g4 + 4 * h) * 2) = w0;
            *(u32x2*)(patch + r * 144 + (32 + 8 * g4 + 4 * h) * 2) = w1;
        }
        asm volatile("s_waitcnt lgkmcnt(0)" ::: "memory");
        u16* ob = cat + (qrow - r) * D + 256 + hd * 64;
#pragma unroll
        for (int it = 0; it < 4; ++it) {
            const int row = 8 * it + (lane >> 3), c = lane & 7;
            *(u32x4*)(ob + (size_t)row * D + 8 * c) = *(const u32x4*)(patch + row * 144 + c * 16);
        }
        asm volatile("s_waitcnt lgkmcnt(0)" ::: "memory");
    }
}

DI void conv_unit(const Params& p, int l, int u) {
    const u16* proj = (const u16*)(p.ws + OFF_PROJ);
    u16* cat = (u16*)(p.ws + OFF_CAT);
    const float* cw = p.conv_w + l * 3 * 256;
    const int tid = otid();
#pragma unroll
    for (int i = 0; i < 4; ++i) {
        const int item = tid + 256 * i, rr = item >> 5, ch = (item & 31) * 8;
        const int row = 32 * u + rr;
        int t, len;
        if (row < MLAT) { t = row & (SEQ - 1); len = SEQ; } else { t = (row - MLAT) & (CTX - 1); len = CTX; }
        const u16* rp = proj + (size_t)row * NIN;
        float y[8];
#pragma unroll
        for (int j = 0; j < 8; ++j) y[j] = 0.f;
#pragma unroll
        for (int tap = 0; tap < 3; ++tap) {
            const int tt = t + tap - 1;
            if (tt >= 0 && tt < len) {
                const u16* np_ = rp + (ptrdiff_t)(tap - 1) * NIN;
                float xi[8], cg_[8]; unpack8(*(const u32x4*)(np_ + C_CX + ch), xi); unpack8(*(const u32x4*)(np_ + C_CC + ch), cg_);
                const f32x4 wa = *(const f32x4*)(cw + tap * 256 + ch), wb2 = *(const f32x4*)(cw + tap * 256 + ch + 4);
                const float w8[8] = {wa.x, wa.y, wa.z, wa.w, wb2.x, wb2.y, wb2.z, wb2.w};
#pragma unroll
                for (int j = 0; j < 8; ++j) y[j] += w8[j] * (cg_[j] * xi[j]);
            }
        }
        float bg[8]; unpack8(*(const u32x4*)(rp + C_CB + ch), bg);
#pragma unroll
        for (int j = 0; j < 8; ++j) y[j] *= bg[j];
        *(u32x4*)(cat + (size_t)row * D + ch) = pack8(y);
    }
}

constexpr int GL_G = 0, GL_LR = 16384, GL_GW = 20480, GL_GB = 24576, GL_QS = 24832, GL_BL = 25856, GL_T0 = 26112;
static_assert(GL_T0 + 5 * T64_B <= LDS_BYTES, "gla lds");

struct GateRegs { u32x2 lr; f32x4 gw; float gb; };
DI GateRegs gla_gate_load(const Params& p, int l, int dir, int hh, size_t row0, int tid) {
    const u16* proj = (const u16*)(p.ws + OFF_PROJ);
    GateRegs g;
    const int tok = tid >> 2, part = tid & 3;
    g.lr = *(const u32x2*)(proj + (row0 + tok) * NIN + C_LR + 16 * dir + 4 * part);
    const int rr = tid >> 4, k4 = (tid & 15) * 4;
    g.gw = *(const f32x4*)(p.gate_w + ((size_t)(l * 2 + dir) * 16 + rr) * 256 + hh * 64 + k4);
    g.gb = p.gate_b[(l * 2 + dir) * 256 + hh * 64 + (tid & 63)];
    return g;
}
DI void gla_gates(unsigned char* lds, const GateRegs& gr, int dir) {
    float* G = (float*)(lds + GL_G); float* LR = (float*)(lds + GL_LR); float* GW = (float*)(lds + GL_GW);
    float* GB = (float*)(lds + GL_GB); float* QS = (float*)(lds + GL_QS); float* BL = (float*)(lds + GL_BL);
    const int tid = otid();
    {
        const int tok = tid >> 2, part = tid & 3;
        const u32x2 w = gr.lr;
        f32x4 f; f.x = bflo(w.x); f.y = bfhi(w.x); f.z = bflo(w.y); f.w = bfhi(w.y);
        *(f32x4*)(LR + tok * 16 + 4 * part) = f;
        const int rr = tid >> 4, k4 = (tid & 15) * 4;
        *(f32x4*)(GW + rr * 64 + k4) = gr.gw;
        if (tid < 64) GB[tid] = gr.gb;
    }
    __syncthreads();
    const int k = tid & 63, q = tid >> 6;
    float gwr[16];
#pragma unroll
    for (int rr = 0; rr < 16; ++rr) gwr[rr] = GW[rr * 64 + k];
    const float gb = GB[k];
    float run = 0.f;
#pragma unroll 4
    for (int i = 0; i < 16; ++i) {
        const int t = dir ? (16 * q + 15 - i) : (16 * q + i);
        float x = gb;
#pragma unroll
        for (int r4 = 0; r4 < 4; ++r4) { const f32x4 lv = *(const f32x4*)(LR + t * 16 + 4 * r4); x += lv.x * gwr[4 * r4] + lv.y * gwr[4 * r4 + 1] + lv.z * gwr[4 * r4 + 2] + lv.w * gwr[4 * r4 + 3]; }
        const float ls = fminf(x, 0.f) - __logf(1.f + __expf(-fabsf(x)));
        run += ls * (1.f / 16.f);
        G[t * 64 + k] = run;
    }
    QS[q * 64 + k] = run;
    __syncthreads();
    float off = 0.f, tot = 0.f;
#pragma unroll
    for (int q2 = 0; q2 < 4; ++q2) { const float v = QS[q2 * 64 + k]; tot += v; if (dir ? (q2 > q) : (q2 < q)) off += v; }
#pragma unroll 4
    for (int i = 0; i < 16; ++i) G[(16 * q + i) * 64 + k] += off;
    if (q == 0) BL[k] = tot;
    __syncthreads();
}

DI void gla_passA_unit(unsigned char* lds, const Params& p, int l, int u) {
    const u16* proj = (const u16*)(p.ws + OFF_PROJ);
    float* GST = (float*)(p.ws + OFF_GST); float* GD = (float*)(p.ws + OFF_GD);
    const float* G = (const float*)(lds + GL_G); const float* BL = (const float*)(lds + GL_BL);
    u16* VT = (u16*)(lds + GL_T0); u16* KT = (u16*)(lds + GL_T0 + T64_B);
    const int tid = otid(), lane = tid & 63, wave = tid >> 6, r = lane & 31, h = lane >> 5;
    const int dir = u & 1, hh = (u >> 1) & 3, cc = u >> 3, b = cc / NCH, jj = cc % NCH;
    const bool isctx = jj < 4; const int j = isctx ? jj : jj - 4;
    const size_t row0 = isctx ? (size_t)MLAT + b * CTX + 64 * j : (size_t)b * SEQ + 64 * j;
    const int c = isctx ? (dir ? 3 - j : j) : 4 + (dir ? 255 - j : j);
    const int seq = (b * 4 + hh) * 2 + dir;
    const GateRegs gr = gla_gate_load(p, l, dir, hh, row0, tid);
    u32x4 kA0, kA1, v0, v1;
    {
        const int tok = tid >> 2, part = tid & 3;
        const u16* kp = proj + (row0 + tok) * NIN + C_GK + hh * 64 + 16 * part;
        const u16* vp = proj + (row0 + tok) * NIN + C_GV + hh * 64 + 16 * part;
        kA0 = *(const u32x4*)kp; kA1 = *(const u32x4*)(kp + 8); v0 = *(const u32x4*)vp; v1 = *(const u32x4*)(vp + 8);
    }
    __syncthreads();
    gla_gates(lds, gr, dir);
    {
        const int tok = tid >> 2, part = tid & 3;
        float kf[16]; { float t0[8], t1[8]; unpack8(kA0, t0); unpack8(kA1, t1);
#pragma unroll
            for (int i = 0; i < 8; ++i) { kf[i] = t0[i]; kf[8 + i] = t1[i]; } }
        const unsigned wv[8] = {v0.x, v0.y, v0.z, v0.w, v1.x, v1.y, v1.z, v1.w};
#pragma unroll
        for (int i = 0; i < 16; ++i) {
            const int kk = 16 * part + i;
            const float e = __expf(BL[kk] - G[tok * 64 + kk]);
            KT[kk * LROW + tok] = f2bf(kf[i] * e);
            VT[kk * LROW + tok] = (u16)((i & 1) ? (wv[i >> 1] >> 16) : (wv[i >> 1] & 0xffffu));
        }
    }
    __syncthreads();
    const int ti = wave >> 1, tj = wave & 1;
    f32x16 acc = zero16();
#pragma unroll
    for (int s = 0; s < 4; ++s) {
        const bf16x8 a = *(const bf16x8*)(KT + (32 * ti + r) * LROW + 16 * s + 8 * h);
        const bf16x8 bb = *(const bf16x8*)(VT + (32 * tj + r) * LROW + 16 * s + 8 * h);
        acc = MFMA32(a, bb, acc);
    }
    float* st = GST + ((size_t)seq * NCH + c) * 4096;
#pragma unroll
    for (int i = 0; i < 16; ++i) st[(32 * ti + crow(i, h)) * 64 + 32 * tj + r] = acc[i];
    if (tid < 64) GD[((size_t)seq * NCH + c) * 64 + tid] = __expf(BL[tid]);
}

DI void gla_scan_phase(const Params& p) {
    float* GST = (float*)(p.ws + OFF_GST); const float* GD = (const float*)(p.ws + OFF_GD);
    const int tid = otid();
    for (int g = blockIdx.x * 256 + tid; g < 16 * 4096; g += gridDim.x * 256) {
        const int seq = g >> 12, e = g & 4095, dk = e >> 6;
        float* st = GST + (size_t)seq * NCH * 4096 + e;
        const float* gd = GD + (size_t)seq * NCH * 64 + dk;
        float S = 0.f;
        for (int c0 = 0; c0 < NCH; c0 += 20) {
            float uu[20], dd[20];
#pragma unroll
            for (int i = 0; i < 20; ++i) { uu[i] = st[(size_t)(c0 + i) * 4096]; dd[i] = gd[(c0 + i) * 64]; }
#pragma unroll
            for (int i = 0; i < 20; ++i) { st[(size_t)(c0 + i) * 4096] = S; S = dd[i] * S + uu[i]; }
        }
    }
}

DI void gla_passC_unit(unsigned char* lds, const Params& p, int l, int u) {
    const u16* proj = (const u16*)(p.ws + OFF_PROJ);
    u16* cat = (u16*)(p.ws + OFF_CAT);
    const float* GST = (const float*)(p.ws + OFF_GST);
    float* G = (float*)(lds + GL_G); const float* BL = (const float*)(lds + GL_BL);
    u16* VT = (u16*)(lds + GL_T0); u16* QT = (u16*)(lds + GL_T0 + T64_B); u16* KK = (u16*)(lds + GL_T0 + 2 * T64_B);
    u16* QB = (u16*)(lds + GL_T0 + 3 * T64_B); u16* SST = (u16*)(lds + GL_T0 + 4 * T64_B); u16* AM = QT;
    const int tid = otid(), lane = tid & 63, wave = tid >> 6, r = lane & 31, h = lane >> 5;
    const int hh = u & 3, cc = u >> 2, b = cc / NCH, jj = cc % NCH;
    const bool isctx = jj < 4; const int j = isctx ? jj : jj - 4;
    if (l == DEPTH - 1 && isctx) return;
    const size_t row0 = isctx ? (size_t)MLAT + b * CTX + 64 * j : (size_t)b * SEQ + 64 * j;
    GateRegs grd[2]; u32x4 qr[2], kr[2], v0, v1, ggr[2]; f32x4 sin_[2][4];
    {
        const int tok = tid >> 2, part = tid & 3;
        const u16* rp = proj + (row0 + tok) * NIN + hh * 64 + 16 * part;
        grd[0] = gla_gate_load(p, l, 0, hh, row0, tid); grd[1] = gla_gate_load(p, l, 1, hh, row0, tid);
        qr[0] = *(const u32x4*)(rp + C_GQ); qr[1] = *(const u32x4*)(rp + C_GQ + 8);
        kr[0] = *(const u32x4*)(rp + C_GK); kr[1] = *(const u32x4*)(rp + C_GK + 8);
        v0 = *(const u32x4*)(rp + C_GV); v1 = *(const u32x4*)(rp + C_GV + 8);
        ggr[0] = *(const u32x4*)(rp + C_GG); ggr[1] = *(const u32x4*)(rp + C_GG + 8);
        const int dk = tid >> 2, dvc = (tid & 3) * 16;
#pragma unroll
        for (int d = 0; d < 2; ++d) {
            const int c = isctx ? (d ? 3 - j : j) : 4 + (d ? 255 - j : j);
            const float* sp = GST + ((size_t)((b * 4 + hh) * 2 + d) * NCH + c) * 4096 + dk * 64 + dvc;
#pragma unroll
            for (int q4 = 0; q4 < 4; ++q4) sin_[d][q4] = *(const f32x4*)(sp + 4 * q4);
        }
    }
    __syncthreads();
    {
        const int tok = tid >> 2, part = tid & 3;
        const unsigned wv[8] = {v0.x, v0.y, v0.z, v0.w, v1.x, v1.y, v1.z, v1.w};
#pragma unroll
        for (int i = 0; i < 16; ++i) VT[(16 * part + i) * LROW + tok] = (u16)((i & 1) ? (wv[i >> 1] >> 16) : (wv[i >> 1] & 0xffffu));
    }
    const int ti = wave >> 1, tj = wave & 1;
    f32x16 o = zero16();
#pragma unroll
    for (int dir = 0; dir < 2; ++dir) {
        gla_gates(lds, grd[dir], dir);
        {
            const int tok = tid >> 2, part = tid & 3;
#pragma unroll
            for (int hf = 0; hf < 2; ++hf) {
                float qv[8], kv[8], a[8], bq[8], ck[8];
                unpack8(qr[hf], qv); unpack8(kr[hf], kv);
#pragma unroll
                for (int i = 0; i < 8; ++i) {
                    const int kk = 16 * part + 8 * hf + i;
                    const float bt = G[tok * 64 + kk], mm = 0.5f * BL[kk], qq = qv[i] * 0.125f;
                    a[i] = qq * __expf(bt - mm); ck[i] = kv[i] * __expf(mm - bt); bq[i] = qq * __expf(bt);
                }
                *(u32x4*)(QT + tok * LROW + 16 * part + 8 * hf) = pack8(a);
                *(u32x4*)(KK + tok * LROW + 16 * part + 8 * hf) = pack8(ck);
                *(u32x4*)(QB + tok * LROW + 16 * part + 8 * hf) = pack8(bq);
            }
            const int dk = tid >> 2, dvc = (tid & 3) * 16;
#pragma unroll
            for (int q4 = 0; q4 < 4; ++q4) { const f32x4 sv = sin_[dir][q4];
                SST[(dvc + 4 * q4 + 0) * LROW + dk] = f2bf(sv.x); SST[(dvc + 4 * q4 + 1) * LROW + dk] = f2bf(sv.y);
                SST[(dvc + 4 * q4 + 2) * LROW + dk] = f2bf(sv.z); SST[(dvc + 4 * q4 + 3) * LROW + dk] = f2bf(sv.w); }
        }
        __syncthreads();
        f32x16 am = zero16();
#pragma unroll
        for (int s = 0; s < 4; ++s) {
            const bf16x8 a = *(const bf16x8*)(QT + (32 * ti + r) * LROW + 16 * s + 8 * h);
            const bf16x8 bb = *(const bf16x8*)(KK + (32 * tj + r) * LROW + 16 * s + 8 * h);
            am = MFMA32(a, bb, am);
        }
        __syncthreads();
#pragma unroll
        for (int i = 0; i < 16; ++i) {
            const int t = 32 * ti + crow(i, h), s = 32 * tj + r;
            const bool keep = dir ? (s >= t) : (s <= t);
            AM[t * LROW + s] = f2bf(keep ? am[i] : 0.f);
        }
        __syncthreads();
#pragma unroll
        for (int s = 0; s < 4; ++s) {
            const bf16x8 a = *(const bf16x8*)(AM + (32 * ti + r) * LROW + 16 * s + 8 * h);
            const bf16x8 bb = *(const bf16x8*)(VT + (32 * tj + r) * LROW + 16 * s + 8 * h);
            o = MFMA32(a, bb, o);
            const bf16x8 a2 = *(const bf16x8*)(QB + (32 * ti + r) * LROW + 16 * s + 8 * h);
            const bf16x8 b2 = *(const bf16x8*)(SST + (32 * tj + r) * LROW + 16 * s + 8 * h);
            o = MFMA32(a2, b2, o);
        }
        __syncthreads();
    }
    float* OF = G;
#pragma unroll
    for (int i = 0; i < 16; ++i) OF[(32 * ti + crow(i, h)) * 64 + 32 * tj + r] = o[i];
    __syncthreads();
    {
        const int t = tid >> 2, dvc = (tid & 3) * 16;
        float ov[16]; float ss = 0.f;
#pragma unroll
        for (int q4 = 0; q4 < 4; ++q4) { const f32x4 v = *(const f32x4*)(OF + t * 64 + dvc + 4 * q4); ov[4 * q4] = v.x; ov[4 * q4 + 1] = v.y; ov[4 * q4 + 2] = v.z; ov[4 * q4 + 3] = v.w; ss += v.x * v.x + v.y * v.y + v.z * v.z + v.w * v.w; }
        ss += __shfl_xor(ss, 1); ss += __shfl_xor(ss, 2);
        const float rs = rsqrtf(ss * (1.f / 64.f) + EPS);
        const float* gn = p.gnorm + l * 64 + dvc;
        u16* op = cat + (row0 + t) * D + 768 + hh * 64 + dvc;
#pragma unroll
        for (int hf = 0; hf < 2; ++hf) {
            float gg[8], ou[8]; unpack8(ggr[hf], gg);
#pragma unroll
            for (int i = 0; i < 8; ++i) ou[i] = ov[8 * hf + i] * rs * gn[8 * hf + i] * siluf(gg[i]);
            *(u32x4*)(op + 8 * hf) = pack8(ou);
        }
    }
}

#define XB_TMO      128
#define XB_XCNT(j)  (256  + 64 * (j))
#define XB_XSUB(j)  (1280 + 64 * (j))
#define XB_XGEN(j)  (2304 + 64 * (j))
#define XB_TOP      3328
#define XB_TOPGEN   3392
#define XCD_BAR_WORDS 3456
#define XB_SPIN_CAP (1u << 18)
DI unsigned xb_ld(unsigned* p)              { return __hip_atomic_load(p, __ATOMIC_RELAXED, __HIP_MEMORY_SCOPE_AGENT); }
DI unsigned xb_add(unsigned* p, unsigned v) { return __hip_atomic_fetch_add(p, v, __ATOMIC_RELAXED, __HIP_MEMORY_SCOPE_AGENT); }
DI unsigned xb_xcc_id() { return (unsigned)__builtin_amdgcn_s_getreg((3 << 11) | 20) & 0xFu; }
#define XB_SPIN(cond, bar) do { unsigned _sp = 0; while (cond) { __builtin_amdgcn_s_sleep(1); \
    if ((++_sp & 255u) == 0u) { if (xb_ld(&(bar)[XB_TMO])) break; if (_sp > XB_SPIN_CAP) { atomicAdd(&(bar)[XB_TMO], 1u); break; } } } } while (0)
struct XcdBarrier { unsigned* bar; unsigned x; volatile LAS unsigned* st; };
DI XcdBarrier xcd_barrier_post(unsigned* bar, volatile LAS unsigned* st) {
    XcdBarrier b; b.bar = bar; b.x = xb_xcc_id(); b.st = st;
    if (threadIdx.x == 0) (void)xb_add(&bar[XB_XCNT(b.x)], 1u);
    return b;
}
DI void xcd_barrier_complete(unsigned* bar, unsigned x, unsigned& nloc, unsigned& nx) {
    const unsigned G = gridDim.x * gridDim.y * gridDim.z;
    unsigned sum, cnt, mine, sp = 0u;
    for (;;) {
        sum = 0u; cnt = 0u; mine = 0u;
#pragma unroll
        for (unsigned j = 0; j < 16; ++j) { const unsigned c = xb_ld(&bar[XB_XCNT(j)]); sum += c; cnt += (c > 0u) ? 1u : 0u; mine = (j == x) ? c : mine; }
        if (sum == G) break;
        __builtin_amdgcn_s_sleep(1);
        if ((++sp & 255u) == 0u) { if (xb_ld(&bar[XB_TMO])) break; if (sp > XB_SPIN_CAP) { atomicAdd(&bar[XB_TMO], 1u); break; } }
    }
    nloc = mine > 0u ? mine : 1u; nx = cnt > 0u ? cnt : 1u;
}
DI void xcd_barrier(const XcdBarrier& b) {
    asm volatile("s_waitcnt vmcnt(0)" ::: "memory");
    __syncthreads();
    if (threadIdx.x == 0) {
        unsigned* bar = b.bar;
        __builtin_amdgcn_s_waitcnt(0);
        unsigned nloc = b.st[0], nx = b.st[1];
        if (nloc == 0u) { xcd_barrier_complete(bar, b.x, nloc, nx); b.st[0] = nloc; b.st[1] = nx; }
        const unsigned old = xb_add(&bar[XB_XSUB(b.x)], 1u);
        const unsigned gen = old / nloc;
        if (old + 1u == (gen + 1u) * nloc) {
            __builtin_amdgcn_fence(__ATOMIC_RELEASE, "agent");
            asm volatile("s_waitcnt vmcnt(0)" ::: "memory");
            const unsigned og = xb_add(&bar[XB_TOP], 1u);
            const unsigned tg = og / nx;
            if (og + 1u == (tg + 1u) * nx) xb_add(&bar[XB_TOPGEN], 1u);
            else XB_SPIN(xb_ld(&bar[XB_TOPGEN]) == tg, bar);
            __builtin_amdgcn_fence(__ATOMIC_ACQUIRE, "agent");
            xb_add(&bar[XB_XGEN(b.x)], 1u);
            asm volatile("s_waitcnt vmcnt(0)" ::: "memory");
        } else {
            XB_SPIN(xb_ld(&bar[XB_XGEN(b.x)]) == gen, bar);
            __builtin_amdgcn_fence(__ATOMIC_ACQUIRE, "agent");
            asm volatile("s_waitcnt vmcnt(0)" ::: "memory");
        }
    }
    __syncthreads();
}

DI void ctx_splitk_phase(unsigned char* lds, const u16* A, int lda, const u16* Bt, int ldb, int K, float* part) {
    const int kq = K >> 2;
    const int G = gridDim.x;
    for (int t = G - 1 - (int)blockIdx.x; t < 128; t += G) {
        const int ks = t & 3, n = (t >> 2) & 7, mt = t >> 5;
        EpiPartial e{part + (size_t)ks * MCTX * D};
        gemm_tile(lds, A + ks * kq, lda, Bt + ks * kq, ldb, kq, MLAT + 128 * mt, n * 128, e);
    }
}

#ifndef REP_G
#define REP_G 1
#endif
#ifndef REP_M
#define REP_M 1
#endif
#ifndef REP_C
#define REP_C 1
#endif
__global__ void __launch_bounds__(256, 2) mega_fwd(Params p) {
    extern __shared__ __attribute__((aligned(16))) unsigned char lds[];
    __shared__ uint4 xb_words;
    cg::grid_group grid = cg::this_grid();
    const int G = gridDim.x;
    if (threadIdx.x == 0) xb_words = make_uint4(0u, 0u, 0u, 0u);
    __syncthreads();
    const XcdBarrier xb = xcd_barrier_post((unsigned*)(p.ws + OFF_BAR), (volatile LAS unsigned*)&xb_words);
    prologue_phase(lds, p);
    if (p.ws == nullptr) grid.sync();
    xcd_barrier(xb);
    u16* wb = (u16*)(p.ws + OFF_WB);
    u16* xn = (u16*)(p.ws + OFF_XN);
    u16* proj = (u16*)(p.ws + OFF_PROJ);
    u16* cat = (u16*)(p.ws + OFF_CAT);
    u16* hb = (u16*)(p.ws + OFF_PROJ);
    float* xc = (float*)(p.ws + OFF_XC);
    const float* mod = (const float*)(p.ws + OFF_MOD);
#pragma unroll 1
    for (int l = 0; l < DEPTH; ++l) {
        const u16* wl = wb + (size_t)l * WL_SIZE;
        const bool last = l == DEPTH - 1;
        norm_phase(p, l, 0);
        xcd_barrier(xb);
        for (int rep = 0; rep < REP_G; ++rep) {
        { EpiProj e{proj, (const float*)(p.ws + OFF_ROPE), (const float*)(p.ws + OFF_ROPE) + 4096}; gemm_phase4(lds, xn, D, wl + WL_IN, D, D, MROWS / 256, NINP / 128, e); }
        xcd_barrier(xb);
        }
        for (int rep = 0; rep < REP_M; ++rep) {
            if (rep) xcd_barrier(xb);
            const int NA = 2048 + (last ? 0 : 32), NGA = 8 * 2 * NCH, NCV = (last ? MLAT : MROWS) / 32;
            for (int u = blockIdx.x; u < NA + NGA + NCV; u += G) {
                if (u < NA) attn_unit(lds, p, l, u);
                else if (u < NA + NGA) gla_passA_unit(lds, p, l, u - NA);
                else conv_unit(p, l, u - NA - NGA);
            }
        }
        xcd_barrier(xb);
        gla_scan_phase(p);
        if (!last) weights_phase(lds, p, l + 1, (16 * 4096 / 256) % G);
        xcd_barrier(xb);
        for (int rep = 0; rep < REP_C; ++rep) {
        for (int u = blockIdx.x; u < 4 * 2 * NCH; u += G) gla_passC_unit(lds, p, l, u);
        xcd_barrier(xb);
        }
        {
            EpiResid e{l == 0 ? p.x : p.out, l == 0 ? p.ctx : xc, p.out, xc, mod + (size_t)l * 3 * 6 * D + 2 * D};
            gemm_phase4(lds, cat, D, wl + WL_OUT, D, D, MLAT / 256, D / 128, e);
            if (!last) ctx_splitk_phase(lds, cat, D, wl + WL_OUT, D, D, (float*)(p.ws + OFF_PART));
        }
        xcd_barrier(xb);
        norm_phase(p, l, 1);
        xcd_barrier(xb);
        for (int rep = 0; rep < REP_G; ++rep) {
        { EpiSwiglu e{hb}; gemm_phase4(lds, xn, D, wl + WL_UP, D, D, (last ? MLAT : MROWS) / 256, 2 * DFF / 128, e); }
        xcd_barrier(xb);
        }
        {
            EpiResid e{p.out, xc, p.out, xc, mod + (size_t)l * 3 * 6 * D + 5 * D};
            gemm_phase4(lds, hb, DFF, wl + WL_DOWN, DFF, DFF, MLAT / 256, D / 128, e);
            if (!last) ctx_splitk_phase(lds, hb, DFF, wl + WL_DOWN, DFF, DFF, (float*)(p.ws + OFF_PART));
        }
        xcd_barrier(xb);
    }
    final_norm_phase(p);
}

extern "C" void kernel_launch(void* const* d_in, const int* in_sizes, int n_in, void* d_out, int out_size, void* d_ws, size_t ws_size, hipStream_t stream) {
    static int grid_blocks = 0;
    if (!grid_blocks) {
        if (ws_size < WS_END) { fprintf(stderr, "kernel_launch: workspace too small: %zu < %zu\n", ws_size, (size_t)WS_END); grid_blocks = -1; return; }
        int dev = 0, cus = 0, per_cu = 0;
        hipGetDevice(&dev);
        hipDeviceGetAttribute(&cus, hipDeviceAttributeMultiprocessorCount, dev);
        if (hipFuncSetAttribute((const void*)mega_fwd, hipFuncAttributeMaxDynamicSharedMemorySize, LDS_BYTES) != hipSuccess) fprintf(stderr, "kernel_launch: hipFuncSetAttribute failed\n");
        hipOccupancyMaxActiveBlocksPerMultiprocessor(&per_cu, (const void*)mega_fwd, 256, LDS_BYTES);
        if (per_cu < 1) per_cu = 1;
        if (per_cu > 2) per_cu = 2;
        grid_blocks = cus * per_cu;
        fprintf(stderr, "kernel_launch: cus %d per_cu %d grid %d\n", cus, per_cu, grid_blocks);
    }
    if (grid_blocks < 0) return;
    Params p{};
    p.x = (const float*)d_in[0]; p.c = (const float*)d_in[1]; p.ctx = (const float*)d_in[2]; p.c_ctx = (const float*)d_in[3];
    p.w_mod = (const float*)d_in[4]; p.b_mod = (const float*)d_in[5]; p.g1 = (const float*)d_in[6]; p.g2 = (const float*)d_in[7];
    p.w_in = (const float*)d_in[8]; p.conv_w = (const float*)d_in[9]; p.sink = (const float*)d_in[10]; p.gate_w = (const float*)d_in[11];
    p.gate_b = (const float*)d_in[12]; p.gnorm = (const float*)d_in[13]; p.w_out = (const float*)d_in[14]; p.w_up = (const float*)d_in[15];
    p.w_down = (const float*)d_in[16]; p.gfinal = (const float*)d_in[17];
    p.out = (float*)d_out; p.ws = (unsigned char*)d_ws;
    (void)hipMemsetAsync((unsigned char*)d_ws + OFF_BAR, 0, XCD_BAR_WORDS * 4, stream);
    void* args[] = {&p};
    hipError_t e = hipLaunchCooperativeKernel((const void*)mega_fwd, dim3(grid_blocks), dim3(256), args, LDS_BYTES, stream);
    if (e != hipSuccess) fprintf(stderr, "cooperative launch failed: %s (grid %d)\n", hipGetErrorString(e), grid_blocks);
}
```

```cpp
#include <hip/hip_runtime.h>
#include <hip/hip_cooperative_groups.h>
#include <cstdio>
#include <cstdint>
namespace cg = cooperative_groups;

#define DI __device__ __forceinline__
#define LAS __attribute__((address_space(3)))
typedef unsigned short u16;
typedef short bf16x8 __attribute__((ext_vector_type(8)));
typedef float f32x16 __attribute__((ext_vector_type(16)));
typedef float f32x4 __attribute__((ext_vector_type(4)));
typedef unsigned u32x4 __attribute__((ext_vector_type(4)));
typedef unsigned u32x2 __attribute__((ext_vector_type(2)));

constexpr int D = 1024, NB = 2, SEQ = 16384, CTX = 256, DEPTH = 4;
constexpr int NIN = 2592, NINP = 2688, DFF = 2816;
constexpr int MLAT = NB * SEQ, MCTX = NB * CTX, MROWS = MLAT + MCTX;
constexpr int C_CX = 0, C_CB = 256, C_CC = 512, C_Q = 768, C_K = 1280, C_V = 1408, C_GQ = 1536, C_GK = 1792, C_GV = 2048, C_GG = 2304, C_LR = 2560;
constexpr int NCH = 260;
constexpr float EPS = 1e-6f;
constexpr int XCD_BAR_WORDS_C = 3456;
constexpr float LOG2E = 1.4426950408889634f;

constexpr size_t WL_IN = 0, WL_OUT = (size_t)NINP * D, WL_UP = WL_OUT + (size_t)D * D, WL_DOWN = WL_UP + (size_t)2 * DFF * D, WL_SIZE = WL_DOWN + (size_t)D * DFF;
constexpr size_t OFF_WB = 0;
constexpr size_t OFF_XN = OFF_WB + WL_SIZE * DEPTH * 2;
constexpr size_t OFF_PROJ = OFF_XN + (size_t)MROWS * D * 2;
constexpr size_t OFF_CAT = OFF_PROJ + (size_t)MROWS * NIN * 2;
constexpr size_t OFF_XC = OFF_CAT + (size_t)MROWS * D * 2;
constexpr size_t OFF_MOD = OFF_XC + (size_t)MCTX * D * 4;
constexpr size_t OFF_ROPE = OFF_MOD + (size_t)DEPTH * 3 * 6 * D * 4;
constexpr size_t OFF_GST = OFF_ROPE + 2 * 256 * 16 * 4;
constexpr size_t OFF_GD = OFF_GST + (size_t)16 * NCH * 4096 * 4;
constexpr size_t OFF_PART = OFF_GD + (size_t)16 * NCH * 64 * 4;
constexpr size_t OFF_BAR = OFF_PART + (size_t)4 * MCTX * D * 4;
constexpr size_t WS_END = OFF_BAR + XCD_BAR_WORDS_C * 4;
static_assert(WS_END <= 536870912ull, "workspace too large");
static_assert((size_t)MROWS * DFF * 2 <= OFF_XC - OFF_PROJ, "h overlay does not fit");

struct Params {
    const float *x, *c, *ctx, *c_ctx, *w_mod, *b_mod, *g1, *g2, *w_in, *conv_w, *sink, *gate_w, *gate_b, *gnorm, *w_out, *w_up, *w_down, *gfinal;
    float* out; unsigned char* ws;
};

constexpr int LROW = 72;
constexpr int TILE_B = 128 * LROW * 2;
constexpr int T64_B = 64 * LROW * 2;
constexpr int LDS_BYTES = 4 * TILE_B;

typedef __bf16 bf16x2_t __attribute__((ext_vector_type(2)));
typedef float f32x2_t __attribute__((ext_vector_type(2)));
DI unsigned pk2(float lo, float hi) { f32x2_t v = {lo, hi}; bf16x2_t r = __builtin_convertvector(v, bf16x2_t); return __builtin_bit_cast(unsigned, r); }
DI u16 f2bf(float x) { return (u16)(pk2(x, 0.f) & 0xffffu); }
DI float bflo(unsigned w) { return __uint_as_float(w << 16); }
DI float bfhi(unsigned w) { return __uint_as_float(w & 0xffff0000u); }
DI float bf2f(u16 v) { return __uint_as_float(((unsigned)v) << 16); }
DI void unpack8(u32x4 v, float (&f)[8]) { f[0] = bflo(v.x); f[1] = bfhi(v.x); f[2] = bflo(v.y); f[3] = bfhi(v.y); f[4] = bflo(v.z); f[5] = bfhi(v.z); f[6] = bflo(v.w); f[7] = bfhi(v.w); }
DI u32x4 pack8(const float (&f)[8]) { u32x4 v; v.x = pk2(f[0], f[1]); v.y = pk2(f[2], f[3]); v.z = pk2(f[4], f[5]); v.w = pk2(f[6], f[7]); return v; }
DI int otid() { int t = threadIdx.x; asm volatile("" : "+v"(t)); return t; }
DI int pi32(int r) { return (r & 0x13) | ((r & 4) << 1) | ((r & 8) >> 1); }
DI int crow(int i, int h) { return (i & 3) + 8 * (i >> 2) + 4 * h; }
DI float wave_sum(float v) {
#pragma unroll
    for (int o = 1; o < 64; o <<= 1) v += __shfl_xor(v, o);
    return v;
}
DI float siluf(float a) { return a * __builtin_amdgcn_rcpf(1.f + __expf(-a)); }
#define MFMA32(a, b, c) __builtin_amdgcn_mfma_f32_32x32x16_bf16((a), (b), (c), 0, 0, 0)
DI f32x16 zero16() { f32x16 z;
#pragma unroll
    for (int i = 0; i < 16; ++i) z[i] = 0.f; return z; }

DI int up_dest(int n) { return n < DFF ? ((n >> 5) * 64 + (n & 31)) : ((((n - DFF) >> 5) * 64) + 32 + ((n - DFF) & 31)); }

template <int MODE>
DI void transpose_item(unsigned char* lds, const float* __restrict__ W, int K, int N, u16* __restrict__ WT, int kb, int nb) {
    float* tile = (float*)lds;
    const int tid = otid(), k0 = kb * 64, n0 = nb * 64;
    __syncthreads();
    {
        const int n = tid & 63, kq = tid >> 6;
#pragma unroll 4
        for (int i = 0; i < 16; ++i) { const int k = kq + 4 * i; tile[k * 65 + n] = (n0 + n < N) ? W[(size_t)(k0 + k) * N + n0 + n] : 0.f; }
    }
    __syncthreads();
    {
        const int ch = tid & 7;
#pragma unroll
        for (int j = 0; j < 2; ++j) {
            const int nn = (tid >> 3) + 32 * j;
            float f[8];
#pragma unroll
            for (int q = 0; q < 8; ++q) f[q] = tile[(8 * ch + q) * 65 + nn];
            const int dest = MODE == 1 ? up_dest(n0 + nn) : (n0 + nn);
            *(u32x4*)(WT + (size_t)dest * K + k0 + 8 * ch) = pack8(f);
        }
    }
}

DI void weights_phase(unsigned char* lds, const Params& p, int lw, int first_blk) {
    u16* wb = (u16*)(p.ws + OFF_WB);
    constexpr int I_IN = 16 * (NINP / 64), I_OUT = 16 * 16, I_UP = 16 * (2 * DFF / 64), I_DOWN = (DFF / 64) * 16, I_L = I_IN + I_OUT + I_UP + I_DOWN;
    const int G = gridDim.x;
    int me = (int)blockIdx.x - first_blk; if (me < 0) me += G;
    for (int it = me; it < I_L; it += G) {
        const int l = lw; int r = it;
        u16* wl = wb + (size_t)l * WL_SIZE;
        if (r < I_IN) { transpose_item<0>(lds, p.w_in + (size_t)l * D * NIN, D, NIN, wl + WL_IN, r / (NINP / 64), r % (NINP / 64)); continue; } r -= I_IN;
        if (r < I_OUT) { transpose_item<0>(lds, p.w_out + (size_t)l * D * D, D, D, wl + WL_OUT, r / 16, r % 16); continue; } r -= I_OUT;
        if (r < I_UP) { transpose_item<1>(lds, p.w_up + (size_t)l * D * 2 * DFF, D, 2 * DFF, wl + WL_UP, r / (2 * DFF / 64), r % (2 * DFF / 64)); continue; } r -= I_UP;
        transpose_item<0>(lds, p.w_down + (size_t)l * DFF * D, DFF, D, wl + WL_DOWN, r / 16, r % 16);
    }
    __syncthreads();
}

DI void prologue_phase(unsigned char* lds, const Params& p) {
    const int tid = otid();
    weights_phase(lds, p, 0, 0);
    __syncthreads();
    float* sv = (float*)lds;
    float* red = sv + 3 * D;
    for (int i = tid; i < 3 * D; i += 256) { const int v = i >> 10, k = i & 1023; const float c = v < 2 ? p.c[v * D + k] : p.c_ctx[k]; sv[i] = siluf(c); }
    __syncthreads();
    float* mod = (float*)(p.ws + OFF_MOD);
    for (int it = blockIdx.x; it < DEPTH * 96; it += gridDim.x) {
        const int l = it / 96, n0 = (it % 96) * 64, n = tid & 63, kq = tid >> 6;
        const float* w = p.w_mod + (size_t)l * D * 6 * D + (size_t)(kq * 256) * 6 * D + n0 + n;
        float a0 = 0.f, a1 = 0.f, a2 = 0.f;
#pragma unroll 8
        for (int k = 0; k < 256; ++k) { const float wv = w[(size_t)k * 6 * D]; const int kk = kq * 256 + k; a0 += sv[kk] * wv; a1 += sv[D + kk] * wv; a2 += sv[2 * D + kk] * wv; }
        red[(kq * 3 + 0) * 64 + n] = a0; red[(kq * 3 + 1) * 64 + n] = a1; red[(kq * 3 + 2) * 64 + n] = a2;
        __syncthreads();
        if (tid < 192) { const int v = tid >> 6, nn = tid & 63; float s = p.b_mod[l * 6 * D + n0 + nn];
#pragma unroll
            for (int q = 0; q < 4; ++q) s += red[(q * 3 + v) * 64 + nn];
            mod[((size_t)l * 3 + v) * 6 * D + n0 + nn] = s; }
        __syncthreads();
    }
    {
        const f32x4* s4 = (const f32x4*)p.ctx; f32x4* d4 = (f32x4*)(p.ws + OFF_XC);
        for (int i = blockIdx.x * 256 + tid; i < MCTX * D / 4; i += gridDim.x * 256) d4[i] = s4[i];
    }
    {
        const int g = blockIdx.x * 256 + tid;
        if (g < 4096) {
            const int pos = g >> 4, i = g & 15;
            const float inv = exp2f(-(float)i * (13.287712379549449f / 16.f));
            const float ang = (float)pos * inv;
            const double a = (double)ang, k = rint(a * 0.15915494309189535), rr = a - k * 6.283185307179586;
            const float rf = (float)rr;
            float* rc = (float*)(p.ws + OFF_ROPE);
            rc[g] = __cosf(rf); rc[4096 + g] = __sinf(rf);
        }
    }
}

DI void norm_phase(const Params& p, int l, int which) {
    const int tid = otid(), lane = tid & 63, wave = tid >> 6;
    const float* lat = (l == 0 && which == 0) ? p.x : p.out;
    const float* cx = (const float*)(p.ws + OFF_XC);
    const float* g = (which == 0 ? p.g1 : p.g2) + l * D;
    const float* mod = (const float*)(p.ws + OFF_MOD) + (size_t)l * 3 * 6 * D;
    u16* xn = (u16*)(p.ws + OFF_XN);
    const int nrows = (l == DEPTH - 1 && which == 1) ? MLAT : MROWS;
    const bool fold = which == 1 || l > 0;
    const float* part = (const float*)(p.ws + OFF_PART);
    const float* fgate = (const float*)(p.ws + OFF_MOD) + (size_t)(which == 1 ? l : l - 1) * 3 * 6 * D + 2 * 6 * D + (which == 1 ? 2 * D : 5 * D);
    const int NW = gridDim.x * 4, gw = blockIdx.x * 4 + wave;
    {
        const int rpw = ((MLAT + NW - 1) / NW + 3) & ~3;
        const int rbeg = gw * rpw, rend = (rbeg + rpw) < MLAT ? (rbeg + rpw) : MLAT;
        int cur_var = -1;
        f32x4 ga[4], sb[4];
        for (int r0 = rbeg; r0 < rend; r0 += 4) {
            const int var = r0 < SEQ ? 0 : 1;
            if (var != cur_var) {
                cur_var = var;
                const float* sh = mod + var * 6 * D + (which == 0 ? 0 : 3 * D);
                const float* sc = sh + D;
#pragma unroll
                for (int j = 0; j < 4; ++j) {
                    const int col = j * 256 + lane * 4;
                    const f32x4 gg = *(const f32x4*)(g + col), s1 = *(const f32x4*)(sc + col);
                    ga[j].x = gg.x * (1.f + s1.x); ga[j].y = gg.y * (1.f + s1.y); ga[j].z = gg.z * (1.f + s1.z); ga[j].w = gg.w * (1.f + s1.w);
                    sb[j] = *(const f32x4*)(sh + col);
                }
            }
            f32x4 v[4][4]; float ss[4];
#pragma unroll
            for (int q = 0; q < 4; ++q) {
                const int row = (r0 + q) < rend ? (r0 + q) : (rend - 1);
#pragma unroll
                for (int j = 0; j < 4; ++j) v[q][j] = *(const f32x4*)(lat + (size_t)row * D + j * 256 + lane * 4);
            }
#pragma unroll
            for (int q = 0; q < 4; ++q) {
                ss[q] = 0.f;
#pragma unroll
                for (int j = 0; j < 4; ++j) ss[q] += v[q][j].x * v[q][j].x + v[q][j].y * v[q][j].y + v[q][j].z * v[q][j].z + v[q][j].w * v[q][j].w;
                ss[q] = wave_sum(ss[q]);
            }
#pragma unroll
            for (int q = 0; q < 4; ++q) {
                if (r0 + q >= rend) continue;
                const float rs = rsqrtf(ss[q] * (1.f / D) + EPS);
#pragma unroll
                for (int j = 0; j < 4; ++j) {
                    f32x4 o;
                    o.x = v[q][j].x * rs * ga[j].x + sb[j].x; o.y = v[q][j].y * rs * ga[j].y + sb[j].y;
                    o.z = v[q][j].z * rs * ga[j].z + sb[j].z; o.w = v[q][j].w * rs * ga[j].w + sb[j].w;
                    u32x2 w; w.x = pk2(o.x, o.y); w.y = pk2(o.z, o.w);
                    *(u32x2*)(xn + (size_t)(r0 + q) * D + j * 256 + lane * 4) = w;
                }
            }
        }
    }
    for (int row = MLAT + gw; row < nrows; row += NW) {
        const float* xr = cx + (size_t)(row - MLAT) * D;
        f32x4 v[4]; float ss = 0.f;
#pragma unroll
        for (int j = 0; j < 4; ++j) v[j] = *(const f32x4*)(xr + j * 256 + lane * 4);
        if (fold) {
            const float* pp = part + (size_t)(row - MLAT) * D;
            float* xw = (float*)(p.ws + OFF_XC) + (size_t)(row - MLAT) * D;
#pragma unroll
            for (int j = 0; j < 4; ++j) {
                const int col = j * 256 + lane * 4;
                const f32x4 gt = *(const f32x4*)(fgate + col);
                const f32x4 p0 = *(const f32x4*)(pp + col), p1 = *(const f32x4*)(pp + (size_t)MCTX * D + col), p2 = *(const f32x4*)(pp + (size_t)2 * MCTX * D + col), p3 = *(const f32x4*)(pp + (size_t)3 * MCTX * D + col);
                v[j].x += gt.x * ((p0.x + p1.x) + (p2.x + p3.x)); v[j].y += gt.y * ((p0.y + p1.y) + (p2.y + p3.y));
                v[j].z += gt.z * ((p0.z + p1.z) + (p2.z + p3.z)); v[j].w += gt.w * ((p0.w + p1.w) + (p2.w + p3.w));
                *(f32x4*)(xw + col) = v[j];
            }
        }
#pragma unroll
        for (int j = 0; j < 4; ++j) ss += v[j].x * v[j].x + v[j].y * v[j].y + v[j].z * v[j].z + v[j].w * v[j].w;
        const float rs = rsqrtf(wave_sum(ss) * (1.f / D) + EPS);
        const float* sh = mod + 2 * 6 * D + (which == 0 ? 0 : 3 * D);
        const float* sc = sh + D;
#pragma unroll
        for (int j = 0; j < 4; ++j) {
            const int col = j * 256 + lane * 4;
            const f32x4 gg = *(const f32x4*)(g + col), s1 = *(const f32x4*)(sc + col), s0 = *(const f32x4*)(sh + col);
            f32x4 o;
            o.x = v[j].x * rs * gg.x * (1.f + s1.x) + s0.x; o.y = v[j].y * rs * gg.y * (1.f + s1.y) + s0.y;
            o.z = v[j].z * rs * gg.z * (1.f + s1.z) + s0.z; o.w = v[j].w * rs * gg.w * (1.f + s1.w) + s0.w;
            u32x2 w; w.x = pk2(o.x, o.y); w.y = pk2(o.z, o.w);
            *(u32x2*)(xn + (size_t)row * D + col) = w;
        }
    }
}

DI void final_norm_phase(const Params& p) {
    const int tid = otid(), lane = tid & 63, wave = tid >> 6;
    const int W = gridDim.x * 4;
    const f32x4 gg0 = *(const f32x4*)(p.gfinal + lane * 4), gg1 = *(const f32x4*)(p.gfinal + 256 + lane * 4), gg2 = *(const f32x4*)(p.gfinal + 512 + lane * 4), gg3 = *(const f32x4*)(p.gfinal + 768 + lane * 4);
    const f32x4 gg[4] = {gg0, gg1, gg2, gg3};
    for (int row0 = blockIdx.x * 4 + wave; row0 < MLAT; row0 += 4 * W) {
        f32x4 v[4][4]; float ss[4];
#pragma unroll
        for (int q = 0; q < 4; ++q) {
            const int row = row0 + q * W;
            ss[q] = 0.f;
#pragma unroll
            for (int j = 0; j < 4; ++j) v[q][j] = row < MLAT ? *(const f32x4*)(p.out + (size_t)row * D + j * 256 + lane * 4) : (f32x4){0.f, 0.f, 0.f, 0.f};
        }
#pragma unroll
        for (int q = 0; q < 4; ++q) {
#pragma unroll
            for (int j = 0; j < 4; ++j) ss[q] += v[q][j].x * v[q][j].x + v[q][j].y * v[q][j].y + v[q][j].z * v[q][j].z + v[q][j].w * v[q][j].w;
            ss[q] = wave_sum(ss[q]);
        }
#pragma unroll
        for (int q = 0; q < 4; ++q) {
            const int row = row0 + q * W;
            if (row >= MLAT) continue;
            const float rs = rsqrtf(ss[q] * (1.f / D) + EPS);
#pragma unroll
            for (int j = 0; j < 4; ++j) {
                f32x4 o; o.x = v[q][j].x * rs * gg[j].x; o.y = v[q][j].y * rs * gg[j].y; o.z = v[q][j].z * rs * gg[j].z; o.w = v[q][j].w * rs * gg[j].w;
                *(f32x4*)(p.out + (size_t)row * D + j * 256 + lane * 4) = o;
            }
        }
    }
}

template <class Epi>
DI void gemm_tile(unsigned char* lds, const u16* __restrict__ A, int lda, const u16* __restrict__ Bt, int ldb, int K, int m0, int n0, const Epi& epi) {
    const int tid = otid(), lane = tid & 63, wave = tid >> 6, wm = wave >> 1, wn = wave & 1, r = lane & 31, h = lane >> 5;
    const u16* ga = A + (size_t)(m0 + (tid >> 3)) * lda + (tid & 7) * 8;
    const u16* gb = Bt + (size_t)(n0 + (tid >> 3)) * ldb + (tid & 7) * 8;
    const int soff = ((tid >> 3) * LROW + (tid & 7) * 8) * 2;
    const int aoff = ((64 * wm + r) * LROW + 8 * h) * 2, boff = TILE_B + ((64 * wn + pi32(r)) * LROW + 8 * h) * 2;
    u32x4 ra[4], rb[4];
    f32x16 acc[2][2];
#pragma unroll
    for (int a = 0; a < 2; ++a)
#pragma unroll
        for (int b = 0; b < 2; ++b) acc[a][b] = zero16();
    const int nk = K >> 6;
#pragma unroll
    for (int i = 0; i < 4; ++i) { ra[i] = *(const u32x4*)(ga + (size_t)(32 * i) * lda); rb[i] = *(const u32x4*)(gb + (size_t)(32 * i) * ldb); }
#pragma unroll
    for (int i = 0; i < 4; ++i) { *(u32x4*)(lds + soff + i * 32 * LROW * 2) = ra[i]; *(u32x4*)(lds + TILE_B + soff + i * 32 * LROW * 2) = rb[i]; }
    __syncthreads();
    for (int kt = 0; kt < nk; ++kt) {
        const bool more = kt + 1 < nk;
        if (more) {
            const int k0 = (kt + 1) * 64;
#pragma unroll
            for (int i = 0; i < 4; ++i) { ra[i] = *(const u32x4*)(ga + (size_t)(32 * i) * lda + k0); rb[i] = *(const u32x4*)(gb + (size_t)(32 * i) * ldb + k0); }
        }
        __builtin_amdgcn_sched_barrier(0);
        const unsigned char* st = lds + (kt & 1) * 2 * TILE_B;
#pragma unroll
        for (int s = 0; s < 4; ++s) {
            bf16x8 af[2], bfr[2];
#pragma unroll
            for (int mi = 0; mi < 2; ++mi) af[mi] = *(const bf16x8*)(st + aoff + mi * 32 * LROW * 2 + s * 32);
#pragma unroll
            for (int ni = 0; ni < 2; ++ni) bfr[ni] = *(const bf16x8*)(st + boff + ni * 32 * LROW * 2 + s * 32);
#pragma unroll
            for (int mi = 0; mi < 2; ++mi)
#pragma unroll
                for (int ni = 0; ni < 2; ++ni) acc[mi][ni] = MFMA32(bfr[ni], af[mi], acc[mi][ni]);
        }
        if (more) {
            unsigned char* sn = lds + ((kt + 1) & 1) * 2 * TILE_B;
#pragma unroll
            for (int i = 0; i < 4; ++i) { *(u32x4*)(sn + soff + i * 32 * LROW * 2) = ra[i]; *(u32x4*)(sn + TILE_B + soff + i * 32 * LROW * 2) = rb[i]; }
        }
        __syncthreads();
    }
    epi.template operator()<2>(acc, m0 + 64 * wm, n0 + 64 * wn, r, h);
}

template <class Epi>
DI void gemm_phase(unsigned char* lds, const u16* A, int lda, const u16* Bt, int ldb, int K, int mtiles, int ntiles, const Epi& epi) {
    const int G = gridDim.x;
    if ((G & 7) == 0) {
        const int xcd = blockIdx.x & 7, local = blockIdx.x >> 3, nlocal = G >> 3;
        const int nmx = (mtiles - xcd + 7) >> 3, total = nmx * ntiles;
        for (int lt = local; lt < total; lt += nlocal) { const int mj = lt / ntiles, n = lt % ntiles; gemm_tile(lds, A, lda, Bt, ldb, K, (xcd + 8 * mj) * 128, n * 128, epi); }
    } else {
        for (int t = blockIdx.x; t < mtiles * ntiles; t += G) gemm_tile(lds, A, lda, Bt, ldb, K, (t / ntiles) * 128, (t % ntiles) * 128, epi);
    }
}

constexpr int A4_B = 256 * LROW * 2, B4_B = 128 * LROW * 2, ST4_B = A4_B + B4_B;
static_assert(ST4_B <= LDS_BYTES, "tile4 lds");
template <class Epi>
DI void gemm_tile4(unsigned char* lds, const u16* __restrict__ A, int lda, const u16* __restrict__ Bt, int ldb, int K, int m0, int n0, const Epi& epi) {
    const int tid = otid(), lane = tid & 63, wave = tid >> 6, wm = wave >> 1, wn = wave & 1, r = lane & 31, h = lane >> 5;
    const u16* ga = A + (size_t)(m0 + (tid >> 3)) * lda + (tid & 7) * 8;
    const u16* gb = Bt + (size_t)(n0 + (tid >> 3)) * ldb + (tid & 7) * 8;
    const int soff = ((tid >> 3) * LROW + (tid & 7) * 8) * 2;
    const int aoff = ((128 * wm + r) * LROW + 8 * h) * 2, boff = A4_B + ((64 * wn + pi32(r)) * LROW + 8 * h) * 2;
    u32x4 ra[8], rb[4];
    f32x16 acc[4][2];
#pragma unroll
    for (int a = 0; a < 4; ++a)
#pragma unroll
        for (int b = 0; b < 2; ++b) acc[a][b] = zero16();
    const int nk = K >> 6;
#pragma unroll
    for (int i = 0; i < 8; ++i) ra[i] = *(const u32x4*)(ga + (size_t)(32 * i) * lda);
#pragma unroll
    for (int i = 0; i < 4; ++i) rb[i] = *(const u32x4*)(gb + (size_t)(32 * i) * ldb);
    for (int kt = 0; kt < nk; ++kt) {
        __syncthreads();
#pragma unroll
        for (int i = 0; i < 8; ++i) *(u32x4*)(lds + soff + i * 32 * LROW * 2) = ra[i];
#pragma unroll
        for (int i = 0; i < 4; ++i) *(u32x4*)(lds + A4_B + soff + i * 32 * LROW * 2) = rb[i];
        __syncthreads();
        {
            const int k0 = (kt + 1 < nk ? kt + 1 : kt) * 64;
#pragma unroll
            for (int i = 0; i < 8; ++i) ra[i] = *(const u32x4*)(ga + (size_t)(32 * i) * lda + k0);
#pragma unroll
            for (int i = 0; i < 4; ++i) rb[i] = *(const u32x4*)(gb + (size_t)(32 * i) * ldb + k0);
        }
        __builtin_amdgcn_sched_barrier(0);
#pragma unroll
        for (int s = 0; s < 4; ++s) {
            bf16x8 af[4], bfr[2];
#pragma unroll
            for (int mi = 0; mi < 4; ++mi) af[mi] = *(const bf16x8*)(lds + aoff + mi * 32 * LROW * 2 + s * 32);
#pragma unroll
            for (int ni = 0; ni < 2; ++ni) bfr[ni] = *(const bf16x8*)(lds + boff + ni * 32 * LROW * 2 + s * 32);
#pragma unroll
            for (int mi = 0; mi < 4; ++mi)
#pragma unroll
                for (int ni = 0; ni < 2; ++ni) acc[mi][ni] = MFMA32(bfr[ni], af[mi], acc[mi][ni]);
        }
    }
    epi.template operator()<4>(acc, m0 + 128 * wm, n0 + 64 * wn, r, h);
}


constexpr int G5_A = 256 * 64, G5_B = 128 * 64, G5_ST = G5_A + G5_B;
static_assert(3 * G5_ST <= LDS_BYTES, "tile5 lds");
template <class Epi>
DI void gemm_tile5(unsigned char* ldsg, const u16* __restrict__ A, int lda, const u16* __restrict__ Bt, int ldb, int K, int m0, int n0, const Epi& epi) {
    LAS unsigned char* lds = (LAS unsigned char*)ldsg;
    const int tid = otid(), lane = tid & 63, wave = __builtin_amdgcn_readfirstlane(tid >> 6), wm = wave >> 1, wn = wave & 1, r = lane & 31, h = lane >> 5;
    const int gl_row = lane >> 2, gl_c = (lane & 3) ^ ((lane >> 4) & 3);
    const u16* gA = A + (size_t)(m0 + 64 * wave + gl_row) * lda + gl_c * 8;
    const u16* gB = Bt + (size_t)(n0 + 32 * wave + gl_row) * ldb + gl_c * 8;
    const int ldsA = wave * 4096, ldsB = G5_A + wave * 2048;
    const int xa = (r >> 2) & 3, pr = pi32(r), xb = (pr >> 2) & 3;
    const int a0 = (128 * wm + r) * 64 + ((h ^ xa) << 4), a1 = (128 * wm + r) * 64 + (((2 + h) ^ xa) << 4);
    const int b0 = G5_A + (64 * wn + pr) * 64 + ((h ^ xb) << 4), b1 = G5_A + (64 * wn + pr) * 64 + (((2 + h) ^ xb) << 4);
    f32x16 acc[4][2];
#pragma unroll
    for (int a = 0; a < 4; ++a)
#pragma unroll
        for (int b = 0; b < 2; ++b) acc[a][b] = zero16();
    const int nk = K >> 5;
#define G5_ISSUE(so_, kt_) do { const int k0_ = ((kt_) < nk ? (kt_) : nk - 1) * 32; \
        _Pragma("unroll") for (int j = 0; j < 4; ++j) __builtin_amdgcn_global_load_lds((const unsigned*)(gA + (size_t)(16 * j) * lda + k0_), (LAS unsigned*)(lds + (so_) + ldsA + j * 1024), 16, 0, 0); \
        _Pragma("unroll") for (int j = 0; j < 2; ++j) __builtin_amdgcn_global_load_lds((const unsigned*)(gB + (size_t)(16 * j) * ldb + k0_), (LAS unsigned*)(lds + (so_) + ldsB + j * 1024), 16, 0, 0); } while (0)
    int st_cur = 0, st_nxt = G5_ST, st_wr = 2 * G5_ST;
    G5_ISSUE(st_cur, 0);
    G5_ISSUE(st_nxt, 1);
    asm volatile("s_waitcnt vmcnt(6)" ::: "memory");
    __builtin_amdgcn_s_barrier();
    asm volatile("" ::: "memory");
    for (int kt = 0; kt < nk; ++kt) {
        G5_ISSUE(st_wr, kt + 2);
        {
            bf16x8 af[2][4], bfr[2][2];
#pragma unroll
            for (int ni = 0; ni < 2; ++ni) { bfr[0][ni] = *(const LAS bf16x8*)(lds + st_cur + b0 + ni * 2048); }
#pragma unroll
            for (int mi = 0; mi < 4; ++mi) { af[0][mi] = *(const LAS bf16x8*)(lds + st_cur + a0 + mi * 2048); }
#pragma unroll
            for (int ni = 0; ni < 2; ++ni) { bfr[1][ni] = *(const LAS bf16x8*)(lds + st_cur + b1 + ni * 2048); }
#pragma unroll
            for (int mi = 0; mi < 4; ++mi) { af[1][mi] = *(const LAS bf16x8*)(lds + st_cur + a1 + mi * 2048); }
            __builtin_amdgcn_sched_barrier(0);
            __builtin_amdgcn_s_setprio(1);
#pragma unroll
            for (int s = 0; s < 2; ++s)
#pragma unroll
                for (int mi = 0; mi < 4; ++mi)
#pragma unroll
                    for (int ni = 0; ni < 2; ++ni) acc[mi][ni] = MFMA32(bfr[s][ni], af[s][mi], acc[mi][ni]);
            __builtin_amdgcn_s_setprio(0);
            __builtin_amdgcn_sched_barrier(0);
        }
        asm volatile("s_waitcnt vmcnt(6)" ::: "memory");
        __builtin_amdgcn_s_barrier();
        asm volatile("" ::: "memory");
        { const int t_ = st_cur; st_cur = st_nxt; st_nxt = st_wr; st_wr = t_; }
    }
    asm volatile("s_waitcnt vmcnt(0)" ::: "memory");
    __builtin_amdgcn_s_barrier();
    asm volatile("" ::: "memory");
#undef G5_ISSUE
    if constexpr (Epi::STAGED == 1) {
        epi.template staged<4>(acc, m0 + 128 * wm, n0 + 64 * wn, r, h, ldsg + wave * (32 * 68 * 4), lane);
        __builtin_amdgcn_s_barrier();
        asm volatile("" ::: "memory");
    } else if constexpr (Epi::STAGED == 2) {
        epi.template stage<4>(acc, wm, wn, m0, n0, r, h, ldsg);
        __syncthreads();
        epi.flush(m0, n0, tid, ldsg);
        __syncthreads();
    } else {
        epi.template operator()<4>(acc, m0 + 128 * wm, n0 + 64 * wn, r, h);
    }
}

template <int GW>
DI void tile_of(int lt, int nmx, int ntiles, int& mj, int& n) {
    const int gsz = nmx * GW, g = lt / gsz, rem = lt - g * gsz;
    const int w = (ntiles - GW * g) < GW ? (ntiles - GW * g) : GW;
    mj = rem / w; n = GW * g + rem - mj * w;
}
template <class Epi>
DI void gemm_phase4(unsigned char* lds, const u16* A, int lda, const u16* Bt, int ldb, int K, int mtiles, int ntiles, const Epi& epi) {
    const int G = gridDim.x;
    if ((G & 7) == 0) {
        const int xcd = blockIdx.x & 7, local = blockIdx.x >> 3, nlocal = G >> 3;
        const int nmx = (mtiles - xcd + 7) >> 3, total = nmx * ntiles;
        for (int lt = local; lt < total; lt += nlocal) { int mj, n; tile_of<8>(lt, nmx, ntiles, mj, n); gemm_tile5(lds, A, lda, Bt, ldb, K, (xcd + 8 * mj) * 256, n * 128, epi); }
    } else {
        for (int t = blockIdx.x; t < mtiles * ntiles; t += G) gemm_tile5(lds, A, lda, Bt, ldb, K, (t / ntiles) * 256, (t % ntiles) * 128, epi);
    }
}

struct EpiProj {
    static constexpr int STAGED = 2;
    static constexpr int ROWB = 272;
    u16* proj; const float* ropec; const float* ropes;
    template <int MI> DI void stage(const f32x16 (&acc)[MI][2], int wm, int wn, int m0, int n0, int r, int h, unsigned char* lds) const {
        const int nb = n0 + 64 * wn;
        const bool isq = nb >= C_Q && nb < C_K, isk = nb >= C_K && nb < C_V;
        const float qs = isq ? 0.125f * LOG2E : 1.f;
#pragma unroll
        for (int mi = 0; mi < MI; ++mi) {
            const int rl = 128 * wm + 32 * mi + r, row = m0 + rl;
            const bool rope = (isq || isk) && row < MLAT;
            const int t = row & (SEQ - 1);
#pragma unroll
            for (int ni = 0; ni < 2; ++ni) {
                float lo[8], hi[8];
#pragma unroll
                for (int j = 0; j < 8; ++j) { lo[j] = acc[mi][ni][j]; hi[j] = acc[mi][ni][8 + j]; }
                if (rope) {
                    const int pos = ni == 0 ? (t >> 6) : (t & 63);
                    const float* cp = ropec + pos * 16 + 8 * h; const float* sp = ropes + pos * 16 + 8 * h;
#pragma unroll
                    for (int j = 0; j < 8; ++j) { const float c = cp[j], s = sp[j], x1 = lo[j], x2 = hi[j]; lo[j] = x1 * c - x2 * s; hi[j] = x2 * c + x1 * s; }
                }
                if (isq) {
#pragma unroll
                    for (int j = 0; j < 8; ++j) { lo[j] *= qs; hi[j] *= qs; }
                }
                unsigned char* d = lds + rl * ROWB + (64 * wn + 32 * ni + 8 * h) * 2;
                *(u32x4*)d = pack8(lo); *(u32x4*)(d + 32) = pack8(hi);
            }
        }
    }
    DI void flush(int m0, int n0, int tid, const unsigned char* lds) const {
#pragma unroll
        for (int k = 0; k < 16; ++k) {
            const int id = tid + 256 * k, row = id >> 4, c = id & 15;
            const u32x4 v = *(const u32x4*)(lds + row * ROWB + c * 16);
            if (n0 + 8 * c < NIN) *(u32x4*)(proj + (size_t)(m0 + row) * NIN + n0 + 8 * c) = v;
        }
    }
    template <int MI> DI void operator()(const f32x16 (&acc)[MI][2], int mb, int nb, int r, int h) const {
        const bool isq = nb >= C_Q && nb < C_K, isk = nb >= C_K && nb < C_V;
        const float qs = isq ? 0.125f * LOG2E : 1.f;
#pragma unroll
        for (int mi = 0; mi < MI; ++mi) {
            const int row = mb + 32 * mi + r;
            u16* rp = proj + (size_t)row * NIN;
            const bool rope = (isq || isk) && row < MLAT;
            const int t = row & (SEQ - 1);
#pragma unroll
            for (int ni = 0; ni < 2; ++ni) {
                float lo[8], hi[8];
#pragma unroll
                for (int j = 0; j < 8; ++j) { lo[j] = acc[mi][ni][j]; hi[j] = acc[mi][ni][8 + j]; }
                if (rope) {
                    const int pos = ni == 0 ? (t >> 6) : (t & 63);
                    const float* cp = ropec + pos * 16 + 8 * h; const float* sp = ropes + pos * 16 + 8 * h;
#pragma unroll
                    for (int j = 0; j < 8; ++j) { const float c = cp[j], s = sp[j], x1 = lo[j], x2 = hi[j]; lo[j] = x1 * c - x2 * s; hi[j] = x2 * c + x1 * s; }
                }
                if (isq) {
#pragma unroll
                    for (int j = 0; j < 8; ++j) { lo[j] *= qs; hi[j] *= qs; }
                }
                const int n = nb + 32 * ni + 8 * h;
                if (n < NIN) *(u32x4*)(rp + n) = pack8(lo);
                if (n + 16 < NIN) *(u32x4*)(rp + n + 16) = pack8(hi);
            }
        }
    }
};
struct EpiResid {
    static constexpr int STAGED = 1;
    const float* src_lat; const float* src_ctx; float* dst_lat; float* dst_ctx; const float* gate;
    template <int MI> DI void staged(const f32x16 (&acc)[MI][2], int mb, int nb, int r, int h, unsigned char* wl, int lane) const {
        const int var = mb < SEQ ? 0 : (mb < MLAT ? 1 : 2);
        const int rr = lane >> 4, c4 = (lane & 15) * 4;
        const f32x4 gt = *(const f32x4*)(gate + var * 6 * D + nb + c4);
        float* W = (float*)wl;
        f32x4 xs[2][8];
#pragma unroll
        for (int s = 0; s < 2; ++s)
#pragma unroll
            for (int it = 0; it < 8; ++it) {
                const int row = mb + 32 * s + 4 * it + rr;
                const float* sp = row < MLAT ? src_lat + (size_t)row * D : src_ctx + (size_t)(row - MLAT) * D;
                xs[s][it] = *(const f32x4*)(sp + nb + c4);
            }
#pragma unroll
        for (int mi = 0; mi < MI; ++mi) {
#pragma unroll
            for (int ni = 0; ni < 2; ++ni)
#pragma unroll
                for (int g = 0; g < 2; ++g) {
                    float* d = W + r * 68 + 32 * ni + 16 * g + 8 * h;
                    f32x4 v0, v1;
                    v0.x = acc[mi][ni][8 * g]; v0.y = acc[mi][ni][8 * g + 1]; v0.z = acc[mi][ni][8 * g + 2]; v0.w = acc[mi][ni][8 * g + 3];
                    v1.x = acc[mi][ni][8 * g + 4]; v1.y = acc[mi][ni][8 * g + 5]; v1.z = acc[mi][ni][8 * g + 6]; v1.w = acc[mi][ni][8 * g + 7];
                    *(f32x4*)d = v0; *(f32x4*)(d + 4) = v1;
                }
            asm volatile("s_waitcnt lgkmcnt(0)" ::: "memory");
#pragma unroll
            for (int it = 0; it < 8; ++it) {
                const int rl = 4 * it + rr, row = mb + 32 * mi + rl;
                const f32x4 a = *(const f32x4*)(W + rl * 68 + c4);
                float* dp = row < MLAT ? dst_lat + (size_t)row * D : dst_ctx + (size_t)(row - MLAT) * D;
                const f32x4 s = xs[mi & 1][it];
                f32x4 o; o.x = s.x + gt.x * a.x; o.y = s.y + gt.y * a.y; o.z = s.z + gt.z * a.z; o.w = s.w + gt.w * a.w;
                *(f32x4*)(dp + nb + c4) = o;
            }
            asm volatile("s_waitcnt lgkmcnt(0)" ::: "memory");
            if (mi + 2 < MI) {
#pragma unroll
                for (int it = 0; it < 8; ++it) {
                    const int row = mb + 32 * (mi + 2) + 4 * it + rr;
                    const float* sp = row < MLAT ? src_lat + (size_t)row * D : src_ctx + (size_t)(row - MLAT) * D;
                    xs[mi & 1][it] = *(const f32x4*)(sp + nb + c4);
                }
            }
        }
    }
    template <int MI> DI void operator()(const f32x16 (&acc)[MI][2], int mb, int nb, int r, int h) const {
        const int var = mb < SEQ ? 0 : (mb < MLAT ? 1 : 2);
        const float* gv = gate + var * 6 * D;
#pragma unroll
        for (int mi = 0; mi < MI; ++mi) {
            const int row = mb + 32 * mi + r;
            const float* sp = row < MLAT ? src_lat + (size_t)row * D : src_ctx + (size_t)(row - MLAT) * D;
            float* dp = row < MLAT ? dst_lat + (size_t)row * D : dst_ctx + (size_t)(row - MLAT) * D;
#pragma unroll
            for (int ni = 0; ni < 2; ++ni)
#pragma unroll
                for (int g = 0; g < 2; ++g) {
                    const int n = nb + 32 * ni + 16 * g + 8 * h;
#pragma unroll
                    for (int q = 0; q < 2; ++q) {
                        const f32x4 s = *(const f32x4*)(sp + n + 4 * q), gt = *(const f32x4*)(gv + n + 4 * q);
                        f32x4 o; o.x = s.x + gt.x * acc[mi][ni][8 * g + 4 * q]; o.y = s.y + gt.y * acc[mi][ni][8 * g + 4 * q + 1];
                        o.z = s.z + gt.z * acc[mi][ni][8 * g + 4 * q + 2]; o.w = s.w + gt.w * acc[mi][ni][8 * g + 4 * q + 3];
                        *(f32x4*)(dp + n + 4 * q) = o;
                    }
                }
        }
    }
};
struct EpiPartial {
    float* part;
    template <int MI> DI void operator()(const f32x16 (&acc)[MI][2], int mb, int nb, int r, int h) const {
#pragma unroll
        for (int mi = 0; mi < MI; ++mi) {
            float* dp = part + (size_t)(mb + 32 * mi + r - MLAT) * D;
#pragma unroll
            for (int ni = 0; ni < 2; ++ni)
#pragma unroll
                for (int g = 0; g < 2; ++g) {
                    const int n = nb + 32 * ni + 16 * g + 8 * h;
                    f32x4 v0, v1;
                    v0.x = acc[mi][ni][8 * g]; v0.y = acc[mi][ni][8 * g + 1]; v0.z = acc[mi][ni][8 * g + 2]; v0.w = acc[mi][ni][8 * g + 3];
                    v1.x = acc[mi][ni][8 * g + 4]; v1.y = acc[mi][ni][8 * g + 5]; v1.z = acc[mi][ni][8 * g + 6]; v1.w = acc[mi][ni][8 * g + 7];
                    *(f32x4*)(dp + n) = v0; *(f32x4*)(dp + n + 4) = v1;
                }
        }
    }
};
struct EpiSwiglu {
    static constexpr int STAGED = 2;
    static constexpr int ROWB = 144;
    u16* hb;
    template <int MI> DI void stage(const f32x16 (&acc)[MI][2], int wm, int wn, int m0, int n0, int r, int h, unsigned char* lds) const {
#pragma unroll
        for (int mi = 0; mi < MI; ++mi) {
            const int rl = 128 * wm + 32 * mi + r;
#pragma unroll
            for (int g = 0; g < 2; ++g) {
                float f[8];
#pragma unroll
                for (int j = 0; j < 8; ++j) f[j] = siluf(acc[mi][0][8 * g + j]) * acc[mi][1][8 * g + j];
                *(u32x4*)(lds + rl * ROWB + (32 * wn + 16 * g + 8 * h) * 2) = pack8(f);
            }
        }
    }
    DI void flush(int m0, int n0, int tid, const unsigned char* lds) const {
#pragma unroll
        for (int k = 0; k < 8; ++k) {
            const int id = tid + 256 * k, row = id >> 3, c = id & 7;
            *(u32x4*)(hb + (size_t)(m0 + row) * DFF + (n0 >> 1) + 8 * c) = *(const u32x4*)(lds + row * ROWB + c * 16);
        }
    }
    template <int MI> DI void operator()(const f32x16 (&acc)[MI][2], int mb, int nb, int r, int h) const {
#pragma unroll
        for (int mi = 0; mi < MI; ++mi) {
            u16* rp = hb + (size_t)(mb + 32 * mi + r) * DFF + (nb >> 1);
#pragma unroll
            for (int g = 0; g < 2; ++g) {
                float f[8];
#pragma unroll
                for (int j = 0; j < 8; ++j) f[j] = siluf(acc[mi][0][8 * g + j]) * acc[mi][1][8 * g + j];
                *(u32x4*)(rp + 16 * g + 8 * h) = pack8(f);
            }
        }
    }
};

DI void attn_unit(unsigned char* lds, const Params& p, int l, int u) {
    const u16* proj = (const u16*)(p.ws + OFF_PROJ);
    u16* cat = (u16*)(p.ws + OFF_CAT);
    const float* ropec = (const float*)(p.ws + OFF_ROPE);
    const float* ropes = ropec + 4096;
    u16* Ks = (u16*)lds; u16* Vt = (u16*)(lds + T64_B);
    const int tid = otid(), lane = tid & 63, wave = tid >> 6, r = lane & 31, h = lane >> 5;
    const bool isctx = u >= 2048;
    int b, hd, qb;
    if (!isctx) { qb = u & 127; hd = (u >> 7) & 7; b = u >> 10; } else { const int cu = u - 2048; qb = cu & 1; hd = (cu >> 1) & 7; b = cu >> 4; }
    const int kvh = hd >> 2;
    const int q0 = 128 * qb + 32 * wave;
    const size_t qrow = (size_t)(isctx ? MLAT + b * CTX : b * SEQ) + q0 + r;
    bf16x8 qf[4];
#pragma unroll
    for (int s = 0; s < 4; ++s) qf[s] = __builtin_bit_cast(bf16x8, *(const u32x4*)(proj + qrow * NIN + C_Q + hd * 64 + 16 * s + 8 * h));
    float m = p.sink[l * 8 + hd] * LOG2E;
    float lsum = (h == 0) ? 1.f : 0.f;
    f32x16 O0 = zero16(), O1 = zero16();
    const int ntiles = isctx ? 4 : 10;
    for (int tile = 0; tile < ntiles; ++tile) {
        const bool local = tile >= 4;
        int tk0 = 0; size_t krow0;
        if (!local) krow0 = (size_t)MLAT + b * CTX + 64 * tile;
        else { tk0 = 128 * qb - 128 + 64 * (tile - 4); if (tk0 < 0 || tk0 >= SEQ) continue; krow0 = (size_t)b * SEQ + tk0; }
        __syncthreads();
        {
            const int key = tid >> 2, part = tid & 3, half = part >> 1, sub = part & 1;
            const u16* kp = proj + (krow0 + key) * NIN + C_K + kvh * 64 + 32 * half + 8 * sub;
            u32x4 w1 = *(const u32x4*)kp, w2 = *(const u32x4*)(kp + 16);
            *(u32x4*)(Ks + key * LROW + 32 * half + 8 * sub) = w1;
            *(u32x4*)(Ks + key * LROW + 32 * half + 16 + 8 * sub) = w2;
        }
        {
            const int key = tid & 63, dc = tid >> 6;
            const u16* vp = proj + (krow0 + key) * NIN + C_V + kvh * 64 + 16 * dc;
            const u32x4 v0 = *(const u32x4*)vp, v1 = *(const u32x4*)(vp + 8);
            const unsigned wv[8] = {v0.x, v0.y, v0.z, v0.w, v1.x, v1.y, v1.z, v1.w};
#pragma unroll
            for (int i = 0; i < 8; ++i) { Vt[(16 * dc + 2 * i) * LROW + key] = (u16)(wv[i] & 0xffffu); Vt[(16 * dc + 2 * i + 1) * LROW + key] = (u16)(wv[i] >> 16); }
        }
        __syncthreads();
        if (local && (tk0 + 63 < q0 - 128 || tk0 > q0 + 31 + 128)) continue;
        const bool needmask = local && !(tk0 >= q0 + 31 - 128 && tk0 + 63 <= q0 + 128);
#pragma unroll
        for (int sub = 0; sub < 2; ++sub) {
            f32x16 s0 = zero16();
#pragma unroll
            for (int s = 0; s < 4; ++s) {
                const bf16x8 ka0 = *(const bf16x8*)(Ks + (32 * sub + pi32(r)) * LROW + 16 * s + 8 * h);
                s0 = MFMA32(ka0, qf[s], s0);
            }
            if (needmask) {
                const int tq = q0 + r;
#pragma unroll
                for (int i = 0; i < 16; ++i) {
                    const int tk = tk0 + 32 * sub + 16 * (i >> 3) + 8 * h + (i & 7);
                    const int d0 = tq - tk;
                    if (d0 > 128 || d0 < -128) s0[i] = -INFINITY;
                }
            }
            float mx = s0[0];
#pragma unroll
            for (int i = 1; i < 16; ++i) mx = fmaxf(mx, s0[i]);
            mx = fmaxf(mx, __shfl_xor(mx, 32));
            const float mn = fmaxf(m, mx);
            const float alpha = __builtin_amdgcn_exp2f(m - mn);
            m = mn;
            float ps = 0.f;
#pragma unroll
            for (int i = 0; i < 16; ++i) { s0[i] = __builtin_amdgcn_exp2f(s0[i] - mn); ps += s0[i]; }
            lsum = lsum * alpha + ps;
            if (__builtin_amdgcn_ballot_w64(alpha != 1.f) != 0ull) {
#pragma unroll
                for (int i = 0; i < 16; ++i) { O0[i] *= alpha; O1[i] *= alpha; }
            }
            bf16x8 pf[2];
            {
                u32x4 w;
                w.x = pk2(s0[0], s0[1]); w.y = pk2(s0[2], s0[3]); w.z = pk2(s0[4], s0[5]); w.w = pk2(s0[6], s0[7]); pf[0] = __builtin_bit_cast(bf16x8, w);
                w.x = pk2(s0[8], s0[9]); w.y = pk2(s0[10], s0[11]); w.z = pk2(s0[12], s0[13]); w.w = pk2(s0[14], s0[15]); pf[1] = __builtin_bit_cast(bf16x8, w);
            }
#pragma unroll
            for (int ks = 0; ks < 2; ++ks) {
                const bf16x8 va0 = *(const bf16x8*)(Vt + r * LROW + 32 * sub + 16 * ks + 8 * h);
                const bf16x8 va1 = *(const bf16x8*)(Vt + (32 + r) * LROW + 32 * sub + 16 * ks + 8 * h);
                O0 = MFMA32(va0, pf[ks], O0); O1 = MFMA32(va1, pf[ks], O1);
            }
        }
    }
    const float lt = lsum + __shfl_xor(lsum, 32);
    const float inv = 1.f / lt;
    {
        unsigned char* patch = lds + 20480 + wave * (32 * 144);
#pragma unroll
        for (int g4 = 0; g4 < 4; ++g4) {
            u32x2 w0, w1;
            w0.x = pk2(O0[4 * g4] * inv, O0[4 * g4 + 1] * inv); w0.y = pk2(O0[4 * g4 + 2] * inv, O0[4 * g4 + 3] * inv);
            w1.x = pk2(O1[4 * g4] * inv, O1[4 * g4 + 1] * inv); w1.y = pk2(O1[4 * g4 + 2] * inv, O1[4 * g4 + 3] * inv);
            *(u32x2*)(patch + r * 144 + (8 * g4 + 4 * h) * 2) = w0;
            *(u32x2*)(patch + r * 144 + (32 + 8 * g4 + 4 * h) * 2) = w1;
        }
        asm volatile("s_waitcnt lgkmcnt(0)" ::: "memory");
        u16* ob = cat + (qrow - r) * D + 256 + hd * 64;
#pragma unroll
        for (int it = 0; it < 4; ++it) {
            const int row = 8 * it + (lane >> 3), c = lane & 7;
            *(u32x4*)(ob + (size_t)row * D + 8 * c) = *(const u32x4*)(patch + row * 144 + c * 16);
        }
        asm volatile("s_waitcnt lgkmcnt(0)" ::: "memory");
    }
}

DI void conv_unit(const Params& p, int l, int u) {
    const u16* proj = (const u16*)(p.ws + OFF_PROJ);
    u16* cat = (u16*)(p.ws + OFF_CAT);
    const float* cw = p.conv_w + l * 3 * 256;
    const int tid = otid();
#pragma unroll
    for (int i = 0; i < 4; ++i) {
        const int item = tid + 256 * i, rr = item >> 5, ch = (item & 31) * 8;
        const int row = 32 * u + rr;
        int t, len;
        if (row < MLAT) { t = row & (SEQ - 1); len = SEQ; } else { t = (row - MLAT) & (CTX - 1); len = CTX; }
        const u16* rp = proj + (size_t)row * NIN;
        float y[8];
#pragma unroll
        for (int j = 0; j < 8; ++j) y[j] = 0.f;
#pragma unroll
        for (int tap = 0; tap < 3; ++tap) {
            const int tt = t + tap - 1;
            if (tt >= 0 && tt < len) {
                const u16* np_ = rp + (ptrdiff_t)(tap - 1) * NIN;
                float xi[8], cg_[8]; unpack8(*(const u32x4*)(np_ + C_CX + ch), xi); unpack8(*(const u32x4*)(np_ + C_CC + ch), cg_);
                const f32x4 wa = *(const f32x4*)(cw + tap * 256 + ch), wb2 = *(const f32x4*)(cw + tap * 256 + ch + 4);
                const float w8[8] = {wa.x, wa.y, wa.z, wa.w, wb2.x, wb2.y, wb2.z, wb2.w};
#pragma unroll
                for (int j = 0; j < 8; ++j) y[j] += w8[j] * (cg_[j] * xi[j]);
            }
        }
        float bg[8]; unpack8(*(const u32x4*)(rp + C_CB + ch), bg);
#pragma unroll
        for (int j = 0; j < 8; ++j) y[j] *= bg[j];
        *(u32x4*)(cat + (size_t)row * D + ch) = pack8(y);
    }
}

constexpr int GL_G = 0, GL_LR = 16384, GL_GW = 20480, GL_GB = 24576, GL_QS = 24832, GL_BL = 25856, GL_T0 = 26112;
static_assert(GL_T0 + 5 * T64_B <= LDS_BYTES, "gla lds");

struct GateRegs { bf16x8 lrf; bf16x8 gwf; float gb; };
DI GateRegs gla_gate_load(const Params& p, int l, int dir, int hh, size_t row0, int tid) {
    const u16* proj = (const u16*)(p.ws + OFF_PROJ);
    const int lane = tid & 63, wave = tid >> 6, ti = wave >> 1, tj = wave & 1, r = lane & 31, h = lane >> 5;
    GateRegs g;
    g.lrf = __builtin_bit_cast(bf16x8, *(const u32x4*)(proj + (row0 + 32 * ti + r) * NIN + C_LR + 16 * dir + 8 * h));
    const float* gw = p.gate_w + ((size_t)(l * 2 + dir) * 16 + 8 * h) * 256 + hh * 64 + 32 * tj + r;
    float f[8];
#pragma unroll
    for (int j = 0; j < 8; ++j) f[j] = gw[j * 256];
    g.gwf = __builtin_bit_cast(bf16x8, pack8(f));
    g.gb = p.gate_b[(l * 2 + dir) * 256 + hh * 64 + 32 * tj + r];
    return g;
}
DI void gla_gates(unsigned char* lds, const GateRegs& gr, int dir) {
    float* G = (float*)(lds + GL_G); float* QS = (float*)(lds + GL_QS); float* BL = (float*)(lds + GL_BL);
    const int tid = otid();
    {
        const int lane = tid & 63, wave = tid >> 6, ti = wave >> 1, tj = wave & 1, r = lane & 31, h = lane >> 5;
        const f32x16 x = MFMA32(gr.lrf, gr.gwf, zero16());
#pragma unroll
        for (int i = 0; i < 16; ++i) {
            const float v = x[i] + gr.gb;
            const float ls = fminf(v, 0.f) - __logf(1.f + __expf(-fabsf(v)));
            G[(32 * ti + crow(i, h)) * 64 + 32 * tj + r] = ls * (1.f / 16.f);
        }
    }
    __syncthreads();
    const int k = tid & 63, q = tid >> 6;
    float run = 0.f;
#pragma unroll 4
    for (int i = 0; i < 16; ++i) {
        const int t = dir ? (16 * q + 15 - i) : (16 * q + i);
        run += G[t * 64 + k];
        G[t * 64 + k] = run;
    }
    QS[q * 64 + k] = run;
    __syncthreads();
    float off = 0.f, tot = 0.f;
#pragma unroll
    for (int q2 = 0; q2 < 4; ++q2) { const float v = QS[q2 * 64 + k]; tot += v; if (dir ? (q2 > q) : (q2 < q)) off += v; }
#pragma unroll 4
    for (int i = 0; i < 16; ++i) G[(16 * q + i) * 64 + k] += off;
    if (q == 0) BL[k] = tot;
    __syncthreads();
}

DI void gla_passA_unit(unsigned char* lds, const Params& p, int l, int u) {
    const u16* proj = (const u16*)(p.ws + OFF_PROJ);
    float* GST = (float*)(p.ws + OFF_GST); float* GD = (float*)(p.ws + OFF_GD);
    const float* G = (const float*)(lds + GL_G); const float* BL = (const float*)(lds + GL_BL);
    u16* VT = (u16*)(lds + GL_T0); u16* KT = (u16*)(lds + GL_T0 + T64_B);
    const int tid = otid(), lane = tid & 63, wave = tid >> 6, r = lane & 31, h = lane >> 5;
    const int dir = u & 1, hh = (u >> 1) & 3, cc = u >> 3, b = cc / NCH, jj = cc % NCH;
    const bool isctx = jj < 4; const int j = isctx ? jj : jj - 4;
    const size_t row0 = isctx ? (size_t)MLAT + b * CTX + 64 * j : (size_t)b * SEQ + 64 * j;
    const int c = isctx ? (dir ? 3 - j : j) : 4 + (dir ? 255 - j : j);
    const int seq = (b * 4 + hh) * 2 + dir;
    const GateRegs gr = gla_gate_load(p, l, dir, hh, row0, tid);
    u32x4 kA0, kA1, v0, v1;
    {
        const int tok = tid >> 2, part = tid & 3;
        const u16* kp = proj + (row0 + tok) * NIN + C_GK + hh * 64 + 16 * part;
        const u16* vp = proj + (row0 + tok) * NIN + C_GV + hh * 64 + 16 * part;
        kA0 = *(const u32x4*)kp; kA1 = *(const u32x4*)(kp + 8); v0 = *(const u32x4*)vp; v1 = *(const u32x4*)(vp + 8);
    }
    __syncthreads();
    gla_gates(lds, gr, dir);
    {
        const int tok = tid >> 2, part = tid & 3;
        float kf[16]; { float t0[8], t1[8]; unpack8(kA0, t0); unpack8(kA1, t1);
#pragma unroll
            for (int i = 0; i < 8; ++i) { kf[i] = t0[i]; kf[8 + i] = t1[i]; } }
        const unsigned wv[8] = {v0.x, v0.y, v0.z, v0.w, v1.x, v1.y, v1.z, v1.w};
#pragma unroll
        for (int i = 0; i < 16; ++i) {
            const int kk = 16 * part + i;
            const float e = __expf(BL[kk] - G[tok * 64 + kk]);
            KT[kk * LROW + tok] = f2bf(kf[i] * e);
            VT[kk * LROW + tok] = (u16)((i & 1) ? (wv[i >> 1] >> 16) : (wv[i >> 1] & 0xffffu));
        }
    }
    __syncthreads();
    const int ti = wave >> 1, tj = wave & 1;
    f32x16 acc = zero16();
#pragma unroll
    for (int s = 0; s < 4; ++s) {
        const bf16x8 a = *(const bf16x8*)(KT + (32 * ti + r) * LROW + 16 * s + 8 * h);
        const bf16x8 bb = *(const bf16x8*)(VT + (32 * tj + r) * LROW + 16 * s + 8 * h);
        acc = MFMA32(a, bb, acc);
    }
    float* st = GST + ((size_t)seq * NCH + c) * 4096;
#pragma unroll
    for (int i = 0; i < 16; ++i) st[(32 * ti + crow(i, h)) * 64 + 32 * tj + r] = acc[i];
    if (tid < 64) GD[((size_t)seq * NCH + c) * 64 + tid] = __expf(BL[tid]);
}

DI void gla_scan_phase(const Params& p) {
    float* GST = (float*)(p.ws + OFF_GST); const float* GD = (const float*)(p.ws + OFF_GD);
    const int tid = otid();
    for (int g = blockIdx.x * 256 + tid; g < 16 * 4096; g += gridDim.x * 256) {
        const int seq = g >> 12, e = g & 4095, dk = e >> 6;
        float* st = GST + (size_t)seq * NCH * 4096 + e;
        const float* gd = GD + (size_t)seq * NCH * 64 + dk;
        float S = 0.f;
        for (int c0 = 0; c0 < NCH; c0 += 20) {
            float uu[20], dd[20];
#pragma unroll
            for (int i = 0; i < 20; ++i) { uu[i] = st[(size_t)(c0 + i) * 4096]; dd[i] = gd[(c0 + i) * 64]; }
#pragma unroll
            for (int i = 0; i < 20; ++i) { st[(size_t)(c0 + i) * 4096] = S; S = dd[i] * S + uu[i]; }
        }
    }
}

DI void gla_passC_unit(unsigned char* lds, const Params& p, int l, int u) {
    const u16* proj = (const u16*)(p.ws + OFF_PROJ);
    u16* cat = (u16*)(p.ws + OFF_CAT);
    const float* GST = (const float*)(p.ws + OFF_GST);
    float* G = (float*)(lds + GL_G); const float* BL = (const float*)(lds + GL_BL);
    u16* VT = (u16*)(lds + GL_T0); u16* QT = (u16*)(lds + GL_T0 + T64_B); u16* KK = (u16*)(lds + GL_T0 + 2 * T64_B);
    u16* QB = (u16*)(lds + GL_T0 + 3 * T64_B); u16* SST = (u16*)(lds + GL_T0 + 4 * T64_B); u16* AM = QT;
    const int tid = otid(), lane = tid & 63, wave = tid >> 6, r = lane & 31, h = lane >> 5;
    const int hh = u & 3, cc = u >> 2, b = cc / NCH, jj = cc % NCH;
    const bool isctx = jj < 4; const int j = isctx ? jj : jj - 4;
    if (l == DEPTH - 1 && isctx) return;
    const size_t row0 = isctx ? (size_t)MLAT + b * CTX + 64 * j : (size_t)b * SEQ + 64 * j;
    GateRegs grd[2]; u32x4 qr[2], kr[2], v0, v1, ggr[2]; f32x4 sin_[2][4];
    {
        const int tok = tid >> 2, part = tid & 3;
        const u16* rp = proj + (row0 + tok) * NIN + hh * 64 + 16 * part;
        grd[0] = gla_gate_load(p, l, 0, hh, row0, tid); grd[1] = gla_gate_load(p, l, 1, hh, row0, tid);
        qr[0] = *(const u32x4*)(rp + C_GQ); qr[1] = *(const u32x4*)(rp + C_GQ + 8);
        kr[0] = *(const u32x4*)(rp + C_GK); kr[1] = *(const u32x4*)(rp + C_GK + 8);
        v0 = *(const u32x4*)(rp + C_GV); v1 = *(const u32x4*)(rp + C_GV + 8);
        ggr[0] = *(const u32x4*)(rp + C_GG); ggr[1] = *(const u32x4*)(rp + C_GG + 8);
        const int dk = tid >> 2, dvc = (tid & 3) * 16;
#pragma unroll
        for (int d = 0; d < 2; ++d) {
            const int c = isctx ? (d ? 3 - j : j) : 4 + (d ? 255 - j : j);
            const float* sp = GST + ((size_t)((b * 4 + hh) * 2 + d) * NCH + c) * 4096 + dk * 64 + dvc;
#pragma unroll
            for (int q4 = 0; q4 < 4; ++q4) sin_[d][q4] = *(const f32x4*)(sp + 4 * q4);
        }
    }
    __syncthreads();
    {
        const int tok = tid >> 2, part = tid & 3;
        const unsigned wv[8] = {v0.x, v0.y, v0.z, v0.w, v1.x, v1.y, v1.z, v1.w};
#pragma unroll
        for (int i = 0; i < 16; ++i) VT[(16 * part + i) * LROW + tok] = (u16)((i & 1) ? (wv[i >> 1] >> 16) : (wv[i >> 1] & 0xffffu));
    }
    const int ti = wave >> 1, tj = wave & 1;
    f32x16 o = zero16();
#pragma unroll
    for (int dir = 0; dir < 2; ++dir) {
        gla_gates(lds, grd[dir], dir);
        {
            const int tok = tid >> 2, part = tid & 3;
#pragma unroll
            for (int hf = 0; hf < 2; ++hf) {
                float qv[8], kv[8], a[8], bq[8], ck[8];
                unpack8(qr[hf], qv); unpack8(kr[hf], kv);
#pragma unroll
                for (int i = 0; i < 8; ++i) {
                    const int kk = 16 * part + 8 * hf + i;
                    const float bt = G[tok * 64 + kk], mm = 0.5f * BL[kk], qq = qv[i] * 0.125f;
                    a[i] = qq * __expf(bt - mm); ck[i] = kv[i] * __expf(mm - bt); bq[i] = qq * __expf(bt);
                }
                *(u32x4*)(QT + tok * LROW + 16 * part + 8 * hf) = pack8(a);
                *(u32x4*)(KK + tok * LROW + 16 * part + 8 * hf) = pack8(ck);
                *(u32x4*)(QB + tok * LROW + 16 * part + 8 * hf) = pack8(bq);
            }
            const int dk = tid >> 2, dvc = (tid & 3) * 16;
#pragma unroll
            for (int q4 = 0; q4 < 4; ++q4) { const f32x4 sv = sin_[dir][q4];
                SST[(dvc + 4 * q4 + 0) * LROW + dk] = f2bf(sv.x); SST[(dvc + 4 * q4 + 1) * LROW + dk] = f2bf(sv.y);
                SST[(dvc + 4 * q4 + 2) * LROW + dk] = f2bf(sv.z); SST[(dvc + 4 * q4 + 3) * LROW + dk] = f2bf(sv.w); }
        }
        __syncthreads();
        f32x16 am = zero16();
#pragma unroll
        for (int s = 0; s < 4; ++s) {
            const bf16x8 a = *(const bf16x8*)(QT + (32 * ti + r) * LROW + 16 * s + 8 * h);
            const bf16x8 bb = *(const bf16x8*)(KK + (32 * tj + r) * LROW + 16 * s + 8 * h);
            am = MFMA32(a, bb, am);
        }
        __syncthreads();
#pragma unroll
        for (int i = 0; i < 16; ++i) {
            const int t = 32 * ti + crow(i, h), s = 32 * tj + r;
            const bool keep = dir ? (s >= t) : (s <= t);
            AM[t * LROW + s] = f2bf(keep ? am[i] : 0.f);
        }
        __syncthreads();
#pragma unroll
        for (int s = 0; s < 4; ++s) {
            const bf16x8 a = *(const bf16x8*)(AM + (32 * ti + r) * LROW + 16 * s + 8 * h);
            const bf16x8 bb = *(const bf16x8*)(VT + (32 * tj + r) * LROW + 16 * s + 8 * h);
            o = MFMA32(a, bb, o);
            const bf16x8 a2 = *(const bf16x8*)(QB + (32 * ti + r) * LROW + 16 * s + 8 * h);
            const bf16x8 b2 = *(const bf16x8*)(SST + (32 * tj + r) * LROW + 16 * s + 8 * h);
            o = MFMA32(a2, b2, o);
        }
        __syncthreads();
    }
    float* OF = G;
#pragma unroll
    for (int i = 0; i < 16; ++i) OF[(32 * ti + crow(i, h)) * 64 + 32 * tj + r] = o[i];
    __syncthreads();
    {
        const int t = tid >> 2, dvc = (tid & 3) * 16;
        float ov[16]; float ss = 0.f;
#pragma unroll
        for (int q4 = 0; q4 < 4; ++q4) { const f32x4 v = *(const f32x4*)(OF + t * 64 + dvc + 4 * q4); ov[4 * q4] = v.x; ov[4 * q4 + 1] = v.y; ov[4 * q4 + 2] = v.z; ov[4 * q4 + 3] = v.w; ss += v.x * v.x + v.y * v.y + v.z * v.z + v.w * v.w; }
        ss += __shfl_xor(ss, 1); ss += __shfl_xor(ss, 2);
        const float rs = rsqrtf(ss * (1.f / 64.f) + EPS);
        const float* gn = p.gnorm + l * 64 + dvc;
        u16* op = cat + (row0 + t) * D + 768 + hh * 64 + dvc;
#pragma unroll
        for (int hf = 0; hf < 2; ++hf) {
            float gg[8], ou[8]; unpack8(ggr[hf], gg);
#pragma unroll
            for (int i = 0; i < 8; ++i) ou[i] = ov[8 * hf + i] * rs * gn[8 * hf + i] * siluf(gg[i]);
            *(u32x4*)(op + 8 * hf) = pack8(ou);
        }
    }
}

#define XB_TMO      128
#define XB_XCNT(j)  (256  + 64 * (j))
#define XB_XSUB(j)  (1280 + 64 * (j))
#define XB_XGEN(j)  (2304 + 64 * (j))
#define XB_TOP      3328
#define XB_TOPGEN   3392
#define XCD_BAR_WORDS 3456
#define XB_SPIN_CAP (1u << 18)
DI unsigned xb_ld(unsigned* p)              { return __hip_atomic_load(p, __ATOMIC_RELAXED, __HIP_MEMORY_SCOPE_AGENT); }
DI unsigned xb_add(unsigned* p, unsigned v) { return __hip_atomic_fetch_add(p, v, __ATOMIC_RELAXED, __HIP_MEMORY_SCOPE_AGENT); }
DI unsigned xb_xcc_id() { return (unsigned)__builtin_amdgcn_s_getreg((3 << 11) | 20) & 0xFu; }
#define XB_SPIN(cond, bar) do { unsigned _sp = 0; while (cond) { __builtin_amdgcn_s_sleep(1); \
    if ((++_sp & 255u) == 0u) { if (xb_ld(&(bar)[XB_TMO])) break; if (_sp > XB_SPIN_CAP) { atomicAdd(&(bar)[XB_TMO], 1u); break; } } } } while (0)
struct XcdBarrier { unsigned* bar; unsigned x; volatile LAS unsigned* st; };
DI XcdBarrier xcd_barrier_post(unsigned* bar, volatile LAS unsigned* st) {
    XcdBarrier b; b.bar = bar; b.x = xb_xcc_id(); b.st = st;
    if (threadIdx.x == 0) (void)xb_add(&bar[XB_XCNT(b.x)], 1u);
    return b;
}
DI void xcd_barrier_complete(unsigned* bar, unsigned x, unsigned& nloc, unsigned& nx) {
    const unsigned G = gridDim.x * gridDim.y * gridDim.z;
    unsigned sum, cnt, mine, sp = 0u;
    for (;;) {
        sum = 0u; cnt = 0u; mine = 0u;
#pragma unroll
        for (unsigned j = 0; j < 16; ++j) { const unsigned c = xb_ld(&bar[XB_XCNT(j)]); sum += c; cnt += (c > 0u) ? 1u : 0u; mine = (j == x) ? c : mine; }
        if (sum == G) break;
        __builtin_amdgcn_s_sleep(1);
        if ((++sp & 255u) == 0u) { if (xb_ld(&bar[XB_TMO])) break; if (sp > XB_SPIN_CAP) { atomicAdd(&bar[XB_TMO], 1u); break; } }
    }
    nloc = mine > 0u ? mine : 1u; nx = cnt > 0u ? cnt : 1u;
}
DI void xcd_barrier(const XcdBarrier& b) {
    asm volatile("s_waitcnt vmcnt(0)" ::: "memory");
    __syncthreads();
    if (threadIdx.x == 0) {
        unsigned* bar = b.bar;
        __builtin_amdgcn_s_waitcnt(0);
        unsigned nloc = b.st[0], nx = b.st[1];
        if (nloc == 0u) { xcd_barrier_complete(bar, b.x, nloc, nx); b.st[0] = nloc; b.st[1] = nx; }
        const unsigned old = xb_add(&bar[XB_XSUB(b.x)], 1u);
        const unsigned gen = old / nloc;
        if (old + 1u == (gen + 1u) * nloc) {
            __builtin_amdgcn_fence(__ATOMIC_RELEASE, "agent");
            asm volatile("s_waitcnt vmcnt(0)" ::: "memory");
            const unsigned og = xb_add(&bar[XB_TOP], 1u);
            const unsigned tg = og / nx;
            if (og + 1u == (tg + 1u) * nx) xb_add(&bar[XB_TOPGEN], 1u);
            else XB_SPIN(xb_ld(&bar[XB_TOPGEN]) == tg, bar);
            __builtin_amdgcn_fence(__ATOMIC_ACQUIRE, "agent");
            xb_add(&bar[XB_XGEN(b.x)], 1u);
            asm volatile("s_waitcnt vmcnt(0)" ::: "memory");
        } else {
            XB_SPIN(xb_ld(&bar[XB_XGEN(b.x)]) == gen, bar);
            __builtin_amdgcn_fence(__ATOMIC_ACQUIRE, "agent");
            asm volatile("s_waitcnt vmcnt(0)" ::: "memory");
        }
    }
    __syncthreads();
}

DI void ctx_splitk_phase(unsigned char* lds, const u16* A, int lda, const u16* Bt, int ldb, int K, float* part) {
    const int kq = K >> 2;
    const int G = gridDim.x;
    for (int t = G - 1 - (int)blockIdx.x; t < 128; t += G) {
        const int ks = t & 3, n = (t >> 2) & 7, mt = t >> 5;
        EpiPartial e{part + (size_t)ks * MCTX * D};
        gemm_tile(lds, A + ks * kq, lda, Bt + ks * kq, ldb, kq, MLAT + 128 * mt, n * 128, e);
    }
}

#ifndef REP_G
#define REP_G 1
#endif
#ifndef REP_M
#define REP_M 1
#endif
#ifndef REP_C
#define REP_C 1
#endif
__global__ void __launch_bounds__(256, 2) mega_fwd(Params p) {
    extern __shared__ __attribute__((aligned(16))) unsigned char lds[];
    __shared__ uint4 xb_words;
    cg::grid_group grid = cg::this_grid();
    const int G = gridDim.x;
    if (threadIdx.x == 0) xb_words = make_uint4(0u, 0u, 0u, 0u);
    __syncthreads();
    const XcdBarrier xb = xcd_barrier_post((unsigned*)(p.ws + OFF_BAR), (volatile LAS unsigned*)&xb_words);
    prologue_phase(lds, p);
    if (p.ws == nullptr) grid.sync();
    xcd_barrier(xb);
    u16* wb = (u16*)(p.ws + OFF_WB);
    u16* xn = (u16*)(p.ws + OFF_XN);
    u16* proj = (u16*)(p.ws + OFF_PROJ);
    u16* cat = (u16*)(p.ws + OFF_CAT);
    u16* hb = (u16*)(p.ws + OFF_PROJ);
    float* xc = (float*)(p.ws + OFF_XC);
    const float* mod = (const float*)(p.ws + OFF_MOD);
#pragma unroll 1
    for (int l = 0; l < DEPTH; ++l) {
        const u16* wl = wb + (size_t)l * WL_SIZE;
        const bool last = l == DEPTH - 1;
        norm_phase(p, l, 0);
        xcd_barrier(xb);
        for (int rep = 0; rep < REP_G; ++rep) {
        { EpiProj e{proj, (const float*)(p.ws + OFF_ROPE), (const float*)(p.ws + OFF_ROPE) + 4096}; gemm_phase4(lds, xn, D, wl + WL_IN, D, D, MROWS / 256, NINP / 128, e); }
        xcd_barrier(xb);
        }
        for (int rep = 0; rep < REP_M; ++rep) {
            if (rep) xcd_barrier(xb);
            const int NA = 2048 + (last ? 0 : 32), NGA = 8 * 2 * NCH, NCV = (last ? MLAT : MROWS) / 32;
            for (int u = blockIdx.x; u < NA + NGA + NCV; u += G) {
                if (u < NA) attn_unit(lds, p, l, u);
                else if (u < NA + NGA) gla_passA_unit(lds, p, l, u - NA);
                else conv_unit(p, l, u - NA - NGA);
            }
        }
        xcd_barrier(xb);
        gla_scan_phase(p);
        if (!last) weights_phase(lds, p, l + 1, (16 * 4096 / 256) % G);
        xcd_barrier(xb);
        for (int rep = 0; rep < REP_C; ++rep) {
        for (int u = blockIdx.x; u < 4 * 2 * NCH; u += G) gla_passC_unit(lds, p, l, u);
        xcd_barrier(xb);
        }
        {
            EpiResid e{l == 0 ? p.x : p.out, l == 0 ? p.ctx : xc, p.out, xc, mod + (size_t)l * 3 * 6 * D + 2 * D};
            gemm_phase4(lds, cat, D, wl + WL_OUT, D, D, MLAT / 256, D / 128, e);
            if (!last) ctx_splitk_phase(lds, cat, D, wl + WL_OUT, D, D, (float*)(p.ws + OFF_PART));
        }
        xcd_barrier(xb);
        norm_phase(p, l, 1);
        xcd_barrier(xb);
        for (int rep = 0; rep < REP_G; ++rep) {
        { EpiSwiglu e{hb}; gemm_phase4(lds, xn, D, wl + WL_UP, D, D, (last ? MLAT : MROWS) / 256, 2 * DFF / 128, e); }
        xcd_barrier(xb);
        }
        {
            EpiResid e{p.out, xc, p.out, xc, mod + (size_t)l * 3 * 6 * D + 5 * D};
            gemm_phase4(lds, hb, DFF, wl + WL_DOWN, DFF, DFF, MLAT / 256, D / 128, e);
            if (!last) ctx_splitk_phase(lds, hb, DFF, wl + WL_DOWN, DFF, DFF, (float*)(p.ws + OFF_PART));
        }
        xcd_barrier(xb);
    }
    final_norm_phase(p);
}

extern "C" void kernel_launch(void* const* d_in, const int* in_sizes, int n_in, void* d_out, int out_size, void* d_ws, size_t ws_size, hipStream_t stream) {
    static int grid_blocks = 0;
    if (!grid_blocks) {
        if (ws_size < WS_END) { fprintf(stderr, "kernel_launch: workspace too small: %zu < %zu\n", ws_size, (size_t)WS_END); grid_blocks = -1; return; }
        int dev = 0, cus = 0, per_cu = 0;
        hipGetDevice(&dev);
        hipDeviceGetAttribute(&cus, hipDeviceAttributeMultiprocessorCount, dev);
        if (hipFuncSetAttribute((const void*)mega_fwd, hipFuncAttributeMaxDynamicSharedMemorySize, LDS_BYTES) != hipSuccess) fprintf(stderr, "kernel_launch: hipFuncSetAttribute failed\n");
        hipOccupancyMaxActiveBlocksPerMultiprocessor(&per_cu, (const void*)mega_fwd, 256, LDS_BYTES);
        if (per_cu < 1) per_cu = 1;
        if (per_cu > 2) per_cu = 2;
        grid_blocks = cus * per_cu;
        fprintf(stderr, "kernel_launch: cus %d per_cu %d grid %d\n", cus, per_cu, grid_blocks);
    }
    if (grid_blocks < 0) return;
    Params p{};
    p.x = (const float*)d_in[0]; p.c = (const float*)d_in[1]; p.ctx = (const float*)d_in[2]; p.c_ctx = (const float*)d_in[3];
    p.w_mod = (const float*)d_in[4]; p.b_mod = (const float*)d_in[5]; p.g1 = (const float*)d_in[6]; p.g2 = (const float*)d_in[7];
    p.w_in = (const float*)d_in[8]; p.conv_w = (const float*)d_in[9]; p.sink = (const float*)d_in[10]; p.gate_w = (const float*)d_in[11];
    p.gate_b = (const float*)d_in[12]; p.gnorm = (const float*)d_in[13]; p.w_out = (const float*)d_in[14]; p.w_up = (const float*)d_in[15];
    p.w_down = (const float*)d_in[16]; p.gfinal = (const float*)d_in[17];
    p.out = (float*)d_out; p.ws = (unsigned char*)d_ws;
    (void)hipMemsetAsync((unsigned char*)d_ws + OFF_BAR, 0, XCD_BAR_WORDS * 4, stream);
    void* args[] = {&p};
    hipError_t e = hipLaunchCooperativeKernel((const void*)mega_fwd, dim3(grid_blocks), dim3(256), args, LDS_BYTES, stream);
    if (e != hipSuccess) fprintf(stderr, "cooperative launch failed: %s (grid %d)\n", hipGetErrorString(e), grid_blocks);
}
```

```cpp
#include <hip/hip_runtime.h>
#include <hip/hip_cooperative_groups.h>
#include <cstdio>
#include <cstdint>
namespace cg = cooperative_groups;

#define DI __device__ __forceinline__
#define LAS __attribute__((address_space(3)))
typedef unsigned short u16;
typedef short bf16x8 __attribute__((ext_vector_type(8)));
typedef float f32x16 __attribute__((ext_vector_type(16)));
typedef float f32x4 __attribute__((ext_vector_type(4)));
typedef unsigned u32x4 __attribute__((ext_vector_type(4)));
typedef unsigned u32x2 __attribute__((ext_vector_type(2)));

constexpr int D = 1024, NB = 2, SEQ = 16384, CTX = 256, DEPTH = 4;
constexpr int NIN = 2592, NINP = 2688, DFF = 2816;
constexpr int MLAT = NB * SEQ, MCTX = NB * CTX, MROWS = MLAT + MCTX;
constexpr int C_CX = 0, C_CB = 256, C_CC = 512, C_Q = 768, C_K = 1280, C_V = 1408, C_GQ = 1536, C_GK = 1792, C_GV = 2048, C_GG = 2304, C_LR = 2560;
constexpr int NCH = 260;
constexpr float EPS = 1e-6f;
constexpr int XCD_BAR_WORDS_C = 3456;
constexpr float LOG2E = 1.4426950408889634f;

constexpr size_t WL_IN = 0, WL_OUT = (size_t)NINP * D, WL_UP = WL_OUT + (size_t)D * D, WL_DOWN = WL_UP + (size_t)2 * DFF * D, WL_SIZE = WL_DOWN + (size_t)D * DFF;
constexpr size_t OFF_WB = 0;
constexpr size_t OFF_XN = OFF_WB + WL_SIZE * DEPTH * 2;
constexpr size_t OFF_PROJ = OFF_XN + (size_t)MROWS * D * 2;
constexpr size_t OFF_CAT = OFF_PROJ + (size_t)MROWS * NIN * 2;
constexpr size_t OFF_XC = OFF_CAT + (size_t)MROWS * D * 2;
constexpr size_t OFF_MOD = OFF_XC + (size_t)MCTX * D * 4;
constexpr size_t OFF_ROPE = OFF_MOD + (size_t)DEPTH * 3 * 6 * D * 4;
constexpr size_t OFF_GST = OFF_ROPE + 2 * 256 * 16 * 4;
constexpr size_t OFF_GD = OFF_GST + (size_t)16 * NCH * 4096 * 4;
constexpr size_t OFF_PART = OFF_GD + (size_t)16 * NCH * 64 * 4;
constexpr size_t OFF_BAR = OFF_PART + (size_t)4 * MCTX * D * 4;
constexpr size_t WS_END = OFF_BAR + XCD_BAR_WORDS_C * 4;
static_assert(WS_END <= 536870912ull, "workspace too large");
static_assert((size_t)MROWS * DFF * 2 <= OFF_XC - OFF_PROJ, "h overlay does not fit");

struct Params {
    const float *x, *c, *ctx, *c_ctx, *w_mod, *b_mod, *g1, *g2, *w_in, *conv_w, *sink, *gate_w, *gate_b, *gnorm, *w_out, *w_up, *w_down, *gfinal;
    float* out; unsigned char* ws;
};

constexpr int LROW = 72;
constexpr int TILE_B = 128 * LROW * 2;
constexpr int T64_B = 64 * LROW * 2;
constexpr int LDS_BYTES = 4 * TILE_B;

typedef __bf16 bf16x2_t __attribute__((ext_vector_type(2)));
typedef float f32x2_t __attribute__((ext_vector_type(2)));
DI unsigned pk2(float lo, float hi) { f32x2_t v = {lo, hi}; bf16x2_t r = __builtin_convertvector(v, bf16x2_t); return __builtin_bit_cast(unsigned, r); }
DI u16 f2bf(float x) { return (u16)(pk2(x, 0.f) & 0xffffu); }
DI float bflo(unsigned w) { return __uint_as_float(w << 16); }
DI float bfhi(unsigned w) { return __uint_as_float(w & 0xffff0000u); }
DI float bf2f(u16 v) { return __uint_as_float(((unsigned)v) << 16); }
DI void unpack8(u32x4 v, float (&f)[8]) { f[0] = bflo(v.x); f[1] = bfhi(v.x); f[2] = bflo(v.y); f[3] = bfhi(v.y); f[4] = bflo(v.z); f[5] = bfhi(v.z); f[6] = bflo(v.w); f[7] = bfhi(v.w); }
DI u32x4 pack8(const float (&f)[8]) { u32x4 v; v.x = pk2(f[0], f[1]); v.y = pk2(f[2], f[3]); v.z = pk2(f[4], f[5]); v.w = pk2(f[6], f[7]); return v; }
DI int otid() { int t = threadIdx.x; asm volatile("" : "+v"(t)); return t; }
DI int pi32(int r) { return (r & 0x13) | ((r & 4) << 1) | ((r & 8) >> 1); }
DI int crow(int i, int h) { return (i & 3) + 8 * (i >> 2) + 4 * h; }
DI float wave_sum(float v) {
#pragma unroll
    for (int o = 1; o < 64; o <<= 1) v += __shfl_xor(v, o);
    return v;
}
DI float siluf(float a) { return a * __builtin_amdgcn_rcpf(1.f + __expf(-a)); }
#define MFMA32(a, b, c) __builtin_amdgcn_mfma_f32_32x32x16_bf16((a), (b), (c), 0, 0, 0)
DI f32x16 zero16() { f32x16 z;
#pragma unroll
    for (int i = 0; i < 16; ++i) z[i] = 0.f; return z; }

DI int up_dest(int n) { return n < DFF ? ((n >> 5) * 64 + (n & 31)) : ((((n - DFF) >> 5) * 64) + 32 + ((n - DFF) & 31)); }

template <int MODE>
DI void transpose_item(unsigned char* lds, const float* __restrict__ W, int K, int N, u16* __restrict__ WT, int kb, int nb) {
    float* tile = (float*)lds;
    const int tid = otid(), k0 = kb * 64, n0 = nb * 64;
    __syncthreads();
    {
        const int n = tid & 63, kq = tid >> 6;
#pragma unroll 4
        for (int i = 0; i < 16; ++i) { const int k = kq + 4 * i; tile[k * 65 + n] = (n0 + n < N) ? W[(size_t)(k0 + k) * N + n0 + n] : 0.f; }
    }
    __syncthreads();
    {
        const int ch = tid & 7;
#pragma unroll
        for (int j = 0; j < 2; ++j) {
            const int nn = (tid >> 3) + 32 * j;
            float f[8];
#pragma unroll
            for (int q = 0; q < 8; ++q) f[q] = tile[(8 * ch + q) * 65 + nn];
            const int dest = MODE == 1 ? up_dest(n0 + nn) : (n0 + nn);
            *(u32x4*)(WT + (size_t)dest * K + k0 + 8 * ch) = pack8(f);
        }
    }
}

DI void weights_phase(unsigned char* lds, const Params& p, int lw, int first_blk) {
    u16* wb = (u16*)(p.ws + OFF_WB);
    constexpr int I_IN = 16 * (NINP / 64), I_OUT = 16 * 16, I_UP = 16 * (2 * DFF / 64), I_DOWN = (DFF / 64) * 16, I_L = I_IN + I_OUT + I_UP + I_DOWN;
    const int G = gridDim.x;
    int me = (int)blockIdx.x - first_blk; if (me < 0) me += G;
    for (int it = me; it < I_L; it += G) {
        const int l = lw; int r = it;
        u16* wl = wb + (size_t)l * WL_SIZE;
        if (r < I_IN) { transpose_item<0>(lds, p.w_in + (size_t)l * D * NIN, D, NIN, wl + WL_IN, r / (NINP / 64), r % (NINP / 64)); continue; } r -= I_IN;
        if (r < I_OUT) { transpose_item<0>(lds, p.w_out + (size_t)l * D * D, D, D, wl + WL_OUT, r / 16, r % 16); continue; } r -= I_OUT;
        if (r < I_UP) { transpose_item<1>(lds, p.w_up + (size_t)l * D * 2 * DFF, D, 2 * DFF, wl + WL_UP, r / (2 * DFF / 64), r % (2 * DFF / 64)); continue; } r -= I_UP;
        transpose_item<0>(lds, p.w_down + (size_t)l * DFF * D, DFF, D, wl + WL_DOWN, r / 16, r % 16);
    }
    __syncthreads();
}

DI void prologue_phase(unsigned char* lds, const Params& p) {
    const int tid = otid();
    weights_phase(lds, p, 0, 0);
    __syncthreads();
    float* sv = (float*)lds;
    float* red = sv + 3 * D;
    for (int i = tid; i < 3 * D; i += 256) { const int v = i >> 10, k = i & 1023; const float c = v < 2 ? p.c[v * D + k] : p.c_ctx[k]; sv[i] = siluf(c); }
    __syncthreads();
    float* mod = (float*)(p.ws + OFF_MOD);
    for (int it = blockIdx.x; it < DEPTH * 96; it += gridDim.x) {
        const int l = it / 96, n0 = (it % 96) * 64, n = tid & 63, kq = tid >> 6;
        const float* w = p.w_mod + (size_t)l * D * 6 * D + (size_t)(kq * 256) * 6 * D + n0 + n;
        float a0 = 0.f, a1 = 0.f, a2 = 0.f;
#pragma unroll 8
        for (int k = 0; k < 256; ++k) { const float wv = w[(size_t)k * 6 * D]; const int kk = kq * 256 + k; a0 += sv[kk] * wv; a1 += sv[D + kk] * wv; a2 += sv[2 * D + kk] * wv; }
        red[(kq * 3 + 0) * 64 + n] = a0; red[(kq * 3 + 1) * 64 + n] = a1; red[(kq * 3 + 2) * 64 + n] = a2;
        __syncthreads();
        if (tid < 192) { const int v = tid >> 6, nn = tid & 63; float s = p.b_mod[l * 6 * D + n0 + nn];
#pragma unroll
            for (int q = 0; q < 4; ++q) s += red[(q * 3 + v) * 64 + nn];
            mod[((size_t)l * 3 + v) * 6 * D + n0 + nn] = s; }
        __syncthreads();
    }
    {
        const f32x4* s4 = (const f32x4*)p.ctx; f32x4* d4 = (f32x4*)(p.ws + OFF_XC);
        for (int i = blockIdx.x * 256 + tid; i < MCTX * D / 4; i += gridDim.x * 256) d4[i] = s4[i];
    }
    {
        const int g = blockIdx.x * 256 + tid;
        if (g < 4096) {
            const int pos = g >> 4, i = g & 15;
            const float inv = exp2f(-(float)i * (13.287712379549449f / 16.f));
            const float ang = (float)pos * inv;
            const double a = (double)ang, k = rint(a * 0.15915494309189535), rr = a - k * 6.283185307179586;
            const float rf = (float)rr;
            float* rc = (float*)(p.ws + OFF_ROPE);
            rc[g] = __cosf(rf); rc[4096 + g] = __sinf(rf);
        }
    }
}

DI void norm_phase(const Params& p, int l, int which) {
    const int tid = otid(), lane = tid & 63, wave = tid >> 6;
    const float* lat = (l == 0 && which == 0) ? p.x : p.out;
    const float* cx = (const float*)(p.ws + OFF_XC);
    const float* g = (which == 0 ? p.g1 : p.g2) + l * D;
    const float* mod = (const float*)(p.ws + OFF_MOD) + (size_t)l * 3 * 6 * D;
    u16* xn = (u16*)(p.ws + OFF_XN);
    const int nrows = (l == DEPTH - 1 && which == 1) ? MLAT : MROWS;
    const bool fold = which == 1 || l > 0;
    const float* part = (const float*)(p.ws + OFF_PART);
    const float* fgate = (const float*)(p.ws + OFF_MOD) + (size_t)(which == 1 ? l : l - 1) * 3 * 6 * D + 2 * 6 * D + (which == 1 ? 2 * D : 5 * D);
    const int NW = gridDim.x * 4, gw = blockIdx.x * 4 + wave;
    {
        const int rpw = ((MLAT + NW - 1) / NW + 3) & ~3;
        const int rbeg = gw * rpw, rend = (rbeg + rpw) < MLAT ? (rbeg + rpw) : MLAT;
        int cur_var = -1;
        f32x4 ga[4], sb[4];
        for (int r0 = rbeg; r0 < rend; r0 += 4) {
            const int var = r0 < SEQ ? 0 : 1;
            if (var != cur_var) {
                cur_var = var;
                const float* sh = mod + var * 6 * D + (which == 0 ? 0 : 3 * D);
                const float* sc = sh + D;
#pragma unroll
                for (int j = 0; j < 4; ++j) {
                    const int col = j * 256 + lane * 4;
                    const f32x4 gg = *(const f32x4*)(g + col), s1 = *(const f32x4*)(sc + col);
                    ga[j].x = gg.x * (1.f + s1.x); ga[j].y = gg.y * (1.f + s1.y); ga[j].z = gg.z * (1.f + s1.z); ga[j].w = gg.w * (1.f + s1.w);
                    sb[j] = *(const f32x4*)(sh + col);
                }
            }
            f32x4 v[4][4]; float ss[4];
#pragma unroll
            for (int q = 0; q < 4; ++q) {
                const int row = (r0 + q) < rend ? (r0 + q) : (rend - 1);
#pragma unroll
                for (int j = 0; j < 4; ++j) v[q][j] = __builtin_nontemporal_load((const f32x4*)(lat + (size_t)row * D + j * 256 + lane * 4));
            }
#pragma unroll
            for (int q = 0; q < 4; ++q) {
                ss[q] = 0.f;
#pragma unroll
                for (int j = 0; j < 4; ++j) ss[q] += v[q][j].x * v[q][j].x + v[q][j].y * v[q][j].y + v[q][j].z * v[q][j].z + v[q][j].w * v[q][j].w;
                ss[q] = wave_sum(ss[q]);
            }
#pragma unroll
            for (int q = 0; q < 4; ++q) {
                if (r0 + q >= rend) continue;
                const float rs = rsqrtf(ss[q] * (1.f / D) + EPS);
#pragma unroll
                for (int j = 0; j < 4; ++j) {
                    f32x4 o;
                    o.x = v[q][j].x * rs * ga[j].x + sb[j].x; o.y = v[q][j].y * rs * ga[j].y + sb[j].y;
                    o.z = v[q][j].z * rs * ga[j].z + sb[j].z; o.w = v[q][j].w * rs * ga[j].w + sb[j].w;
                    u32x2 w; w.x = pk2(o.x, o.y); w.y = pk2(o.z, o.w);
                    *(u32x2*)(xn + (size_t)(r0 + q) * D + j * 256 + lane * 4) = w;
                }
            }
        }
    }
    for (int row = MLAT + gw; row < nrows; row += NW) {
        const float* xr = cx + (size_t)(row - MLAT) * D;
        f32x4 v[4]; float ss = 0.f;
#pragma unroll
        for (int j = 0; j < 4; ++j) v[j] = *(const f32x4*)(xr + j * 256 + lane * 4);
        if (fold) {
            const float* pp = part + (size_t)(row - MLAT) * D;
            float* xw = (float*)(p.ws + OFF_XC) + (size_t)(row - MLAT) * D;
#pragma unroll
            for (int j = 0; j < 4; ++j) {
                const int col = j * 256 + lane * 4;
                const f32x4 gt = *(const f32x4*)(fgate + col);
                const f32x4 p0 = *(const f32x4*)(pp + col), p1 = *(const f32x4*)(pp + (size_t)MCTX * D + col), p2 = *(const f32x4*)(pp + (size_t)2 * MCTX * D + col), p3 = *(const f32x4*)(pp + (size_t)3 * MCTX * D + col);
                v[j].x += gt.x * ((p0.x + p1.x) + (p2.x + p3.x)); v[j].y += gt.y * ((p0.y + p1.y) + (p2.y + p3.y));
                v[j].z += gt.z * ((p0.z + p1.z) + (p2.z + p3.z)); v[j].w += gt.w * ((p0.w + p1.w) + (p2.w + p3.w));
                *(f32x4*)(xw + col) = v[j];
            }
        }
#pragma unroll
        for (int j = 0; j < 4; ++j) ss += v[j].x * v[j].x + v[j].y * v[j].y + v[j].z * v[j].z + v[j].w * v[j].w;
        const float rs = rsqrtf(wave_sum(ss) * (1.f / D) + EPS);
        const float* sh = mod + 2 * 6 * D + (which == 0 ? 0 : 3 * D);
        const float* sc = sh + D;
#pragma unroll
        for (int j = 0; j < 4; ++j) {
            const int col = j * 256 + lane * 4;
            const f32x4 gg = *(const f32x4*)(g + col), s1 = *(const f32x4*)(sc + col), s0 = *(const f32x4*)(sh + col);
            f32x4 o;
            o.x = v[j].x * rs * gg.x * (1.f + s1.x) + s0.x; o.y = v[j].y * rs * gg.y * (1.f + s1.y) + s0.y;
            o.z = v[j].z * rs * gg.z * (1.f + s1.z) + s0.z; o.w = v[j].w * rs * gg.w * (1.f + s1.w) + s0.w;
            u32x2 w; w.x = pk2(o.x, o.y); w.y = pk2(o.z, o.w);
            *(u32x2*)(xn + (size_t)row * D + col) = w;
        }
    }
}

DI void final_norm_phase(const Params& p) {
    const int tid = otid(), lane = tid & 63, wave = tid >> 6;
    const int W = gridDim.x * 4;
    const f32x4 gg0 = *(const f32x4*)(p.gfinal + lane * 4), gg1 = *(const f32x4*)(p.gfinal + 256 + lane * 4), gg2 = *(const f32x4*)(p.gfinal + 512 + lane * 4), gg3 = *(const f32x4*)(p.gfinal + 768 + lane * 4);
    const f32x4 gg[4] = {gg0, gg1, gg2, gg3};
    for (int row0 = blockIdx.x * 4 + wave; row0 < MLAT; row0 += 4 * W) {
        f32x4 v[4][4]; float ss[4];
#pragma unroll
        for (int q = 0; q < 4; ++q) {
            const int row = row0 + q * W;
            ss[q] = 0.f;
#pragma unroll
            for (int j = 0; j < 4; ++j) v[q][j] = row < MLAT ? __builtin_nontemporal_load((const f32x4*)(p.out + (size_t)row * D + j * 256 + lane * 4)) : (f32x4){0.f, 0.f, 0.f, 0.f};
        }
#pragma unroll
        for (int q = 0; q < 4; ++q) {
#pragma unroll
            for (int j = 0; j < 4; ++j) ss[q] += v[q][j].x * v[q][j].x + v[q][j].y * v[q][j].y + v[q][j].z * v[q][j].z + v[q][j].w * v[q][j].w;
            ss[q] = wave_sum(ss[q]);
        }
#pragma unroll
        for (int q = 0; q < 4; ++q) {
            const int row = row0 + q * W;
            if (row >= MLAT) continue;
            const float rs = rsqrtf(ss[q] * (1.f / D) + EPS);
#pragma unroll
            for (int j = 0; j < 4; ++j) {
                f32x4 o; o.x = v[q][j].x * rs * gg[j].x; o.y = v[q][j].y * rs * gg[j].y; o.z = v[q][j].z * rs * gg[j].z; o.w = v[q][j].w * rs * gg[j].w;
                __builtin_nontemporal_store(o, (f32x4*)(p.out + (size_t)row * D + j * 256 + lane * 4));
            }
        }
    }
}

template <class Epi>
DI void gemm_tile(unsigned char* lds, const u16* __restrict__ A, int lda, const u16* __restrict__ Bt, int ldb, int K, int m0, int n0, const Epi& epi) {
    const int tid = otid(), lane = tid & 63, wave = tid >> 6, wm = wave >> 1, wn = wave & 1, r = lane & 31, h = lane >> 5;
    const u16* ga = A + (size_t)(m0 + (tid >> 3)) * lda + (tid & 7) * 8;
    const u16* gb = Bt + (size_t)(n0 + (tid >> 3)) * ldb + (tid & 7) * 8;
    const int soff = ((tid >> 3) * LROW + (tid & 7) * 8) * 2;
    const int aoff = ((64 * wm + r) * LROW + 8 * h) * 2, boff = TILE_B + ((64 * wn + pi32(r)) * LROW + 8 * h) * 2;
    u32x4 ra[4], rb[4];
    f32x16 acc[2][2];
#pragma unroll
    for (int a = 0; a < 2; ++a)
#pragma unroll
        for (int b = 0; b < 2; ++b) acc[a][b] = zero16();
    const int nk = K >> 6;
#pragma unroll
    for (int i = 0; i < 4; ++i) { ra[i] = *(const u32x4*)(ga + (size_t)(32 * i) * lda); rb[i] = *(const u32x4*)(gb + (size_t)(32 * i) * ldb); }
#pragma unroll
    for (int i = 0; i < 4; ++i) { *(u32x4*)(lds + soff + i * 32 * LROW * 2) = ra[i]; *(u32x4*)(lds + TILE_B + soff + i * 32 * LROW * 2) = rb[i]; }
    __syncthreads();
    for (int kt = 0; kt < nk; ++kt) {
        const bool more = kt + 1 < nk;
        if (more) {
            const int k0 = (kt + 1) * 64;
#pragma unroll
            for (int i = 0; i < 4; ++i) { ra[i] = *(const u32x4*)(ga + (size_t)(32 * i) * lda + k0); rb[i] = *(const u32x4*)(gb + (size_t)(32 * i) * ldb + k0); }
        }
        __builtin_amdgcn_sched_barrier(0);
        const unsigned char* st = lds + (kt & 1) * 2 * TILE_B;
#pragma unroll
        for (int s = 0; s < 4; ++s) {
            bf16x8 af[2], bfr[2];
#pragma unroll
            for (int mi = 0; mi < 2; ++mi) af[mi] = *(const bf16x8*)(st + aoff + mi * 32 * LROW * 2 + s * 32);
#pragma unroll
            for (int ni = 0; ni < 2; ++ni) bfr[ni] = *(const bf16x8*)(st + boff + ni * 32 * LROW * 2 + s * 32);
#pragma unroll
            for (int mi = 0; mi < 2; ++mi)
#pragma unroll
                for (int ni = 0; ni < 2; ++ni) acc[mi][ni] = MFMA32(bfr[ni], af[mi], acc[mi][ni]);
        }
        if (more) {
            unsigned char* sn = lds + ((kt + 1) & 1) * 2 * TILE_B;
#pragma unroll
            for (int i = 0; i < 4; ++i) { *(u32x4*)(sn + soff + i * 32 * LROW * 2) = ra[i]; *(u32x4*)(sn + TILE_B + soff + i * 32 * LROW * 2) = rb[i]; }
        }
        __syncthreads();
    }
    epi.template operator()<2>(acc, m0 + 64 * wm, n0 + 64 * wn, r, h);
}

template <class Epi>
DI void gemm_phase(unsigned char* lds, const u16* A, int lda, const u16* Bt, int ldb, int K, int mtiles, int ntiles, const Epi& epi) {
    const int G = gridDim.x;
    if ((G & 7) == 0) {
        const int xcd = blockIdx.x & 7, local = blockIdx.x >> 3, nlocal = G >> 3;
        const int nmx = (mtiles - xcd + 7) >> 3, total = nmx * ntiles;
        for (int lt = local; lt < total; lt += nlocal) { const int mj = lt / ntiles, n = lt % ntiles; gemm_tile(lds, A, lda, Bt, ldb, K, (xcd + 8 * mj) * 128, n * 128, epi); }
    } else {
        for (int t = blockIdx.x; t < mtiles * ntiles; t += G) gemm_tile(lds, A, lda, Bt, ldb, K, (t / ntiles) * 128, (t % ntiles) * 128, epi);
    }
}

constexpr int A4_B = 256 * LROW * 2, B4_B = 128 * LROW * 2, ST4_B = A4_B + B4_B;
static_assert(ST4_B <= LDS_BYTES, "tile4 lds");
template <class Epi>
DI void gemm_tile4(unsigned char* lds, const u16* __restrict__ A, int lda, const u16* __restrict__ Bt, int ldb, int K, int m0, int n0, const Epi& epi) {
    const int tid = otid(), lane = tid & 63, wave = tid >> 6, wm = wave >> 1, wn = wave & 1, r = lane & 31, h = lane >> 5;
    const u16* ga = A + (size_t)(m0 + (tid >> 3)) * lda + (tid & 7) * 8;
    const u16* gb = Bt + (size_t)(n0 + (tid >> 3)) * ldb + (tid & 7) * 8;
    const int soff = ((tid >> 3) * LROW + (tid & 7) * 8) * 2;
    const int aoff = ((128 * wm + r) * LROW + 8 * h) * 2, boff = A4_B + ((64 * wn + pi32(r)) * LROW + 8 * h) * 2;
    u32x4 ra[8], rb[4];
    f32x16 acc[4][2];
#pragma unroll
    for (int a = 0; a < 4; ++a)
#pragma unroll
        for (int b = 0; b < 2; ++b) acc[a][b] = zero16();
    const int nk = K >> 6;
#pragma unroll
    for (int i = 0; i < 8; ++i) ra[i] = *(const u32x4*)(ga + (size_t)(32 * i) * lda);
#pragma unroll
    for (int i = 0; i < 4; ++i) rb[i] = *(const u32x4*)(gb + (size_t)(32 * i) * ldb);
    for (int kt = 0; kt < nk; ++kt) {
        __syncthreads();
#pragma unroll
        for (int i = 0; i < 8; ++i) *(u32x4*)(lds + soff + i * 32 * LROW * 2) = ra[i];
#pragma unroll
        for (int i = 0; i < 4; ++i) *(u32x4*)(lds + A4_B + soff + i * 32 * LROW * 2) = rb[i];
        __syncthreads();
        {
            const int k0 = (kt + 1 < nk ? kt + 1 : kt) * 64;
#pragma unroll
            for (int i = 0; i < 8; ++i) ra[i] = *(const u32x4*)(ga + (size_t)(32 * i) * lda + k0);
#pragma unroll
            for (int i = 0; i < 4; ++i) rb[i] = *(const u32x4*)(gb + (size_t)(32 * i) * ldb + k0);
        }
        __builtin_amdgcn_sched_barrier(0);
#pragma unroll
        for (int s = 0; s < 4; ++s) {
            bf16x8 af[4], bfr[2];
#pragma unroll
            for (int mi = 0; mi < 4; ++mi) af[mi] = *(const bf16x8*)(lds + aoff + mi * 32 * LROW * 2 + s * 32);
#pragma unroll
            for (int ni = 0; ni < 2; ++ni) bfr[ni] = *(const bf16x8*)(lds + boff + ni * 32 * LROW * 2 + s * 32);
#pragma unroll
            for (int mi = 0; mi < 4; ++mi)
#pragma unroll
                for (int ni = 0; ni < 2; ++ni) acc[mi][ni] = MFMA32(bfr[ni], af[mi], acc[mi][ni]);
        }
    }
    epi.template operator()<4>(acc, m0 + 128 * wm, n0 + 64 * wn, r, h);
}


constexpr int G5_A = 256 * 64, G5_B = 128 * 64, G5_ST = G5_A + G5_B;
static_assert(3 * G5_ST <= LDS_BYTES, "tile5 lds");
template <class Epi>
DI void gemm_tile5(unsigned char* ldsg, const u16* __restrict__ A, int lda, const u16* __restrict__ Bt, int ldb, int K, int m0, int n0, const Epi& epi) {
    LAS unsigned char* lds = (LAS unsigned char*)ldsg;
    const int tid = otid(), lane = tid & 63, wave = __builtin_amdgcn_readfirstlane(tid >> 6), wm = wave >> 1, wn = wave & 1, r = lane & 31, h = lane >> 5;
    const int gl_row = lane >> 2, gl_c = (lane & 3) ^ ((lane >> 4) & 3);
    const u16* gA = A + (size_t)(m0 + 64 * wave + gl_row) * lda + gl_c * 8;
    const u16* gB = Bt + (size_t)(n0 + 32 * wave + gl_row) * ldb + gl_c * 8;
    const int ldsA = wave * 4096, ldsB = G5_A + wave * 2048;
    const int xa = (r >> 2) & 3, pr = pi32(r), xb = (pr >> 2) & 3;
    const int a0 = (128 * wm + r) * 64 + ((h ^ xa) << 4), a1 = (128 * wm + r) * 64 + (((2 + h) ^ xa) << 4);
    const int b0 = G5_A + (64 * wn + pr) * 64 + ((h ^ xb) << 4), b1 = G5_A + (64 * wn + pr) * 64 + (((2 + h) ^ xb) << 4);
    f32x16 acc[4][2];
#pragma unroll
    for (int a = 0; a < 4; ++a)
#pragma unroll
        for (int b = 0; b < 2; ++b) acc[a][b] = zero16();
    const int nk = K >> 5;
#define G5_ISSUE(so_, kt_) do { const int k0_ = ((kt_) < nk ? (kt_) : nk - 1) * 32; \
        _Pragma("unroll") for (int j = 0; j < 4; ++j) __builtin_amdgcn_global_load_lds((const unsigned*)(gA + (size_t)(16 * j) * lda + k0_), (LAS unsigned*)(lds + (so_) + ldsA + j * 1024), 16, 0, 0); \
        _Pragma("unroll") for (int j = 0; j < 2; ++j) __builtin_amdgcn_global_load_lds((const unsigned*)(gB + (size_t)(16 * j) * ldb + k0_), (LAS unsigned*)(lds + (so_) + ldsB + j * 1024), 16, 0, 0); } while (0)
    int st_cur = 0, st_nxt = G5_ST, st_wr = 2 * G5_ST;
    G5_ISSUE(st_cur, 0);
    G5_ISSUE(st_nxt, 1);
    asm volatile("s_waitcnt vmcnt(6)" ::: "memory");
    __builtin_amdgcn_s_barrier();
    asm volatile("" ::: "memory");
    for (int kt = 0; kt < nk; ++kt) {
        G5_ISSUE(st_wr, kt + 2);
        {
            bf16x8 af[2][4], bfr[2][2];
#pragma unroll
            for (int ni = 0; ni < 2; ++ni) { bfr[0][ni] = *(const LAS bf16x8*)(lds + st_cur + b0 + ni * 2048); }
#pragma unroll
            for (int mi = 0; mi < 4; ++mi) { af[0][mi] = *(const LAS bf16x8*)(lds + st_cur + a0 + mi * 2048); }
#pragma unroll
            for (int ni = 0; ni < 2; ++ni) { bfr[1][ni] = *(const LAS bf16x8*)(lds + st_cur + b1 + ni * 2048); }
#pragma unroll
            for (int mi = 0; mi < 4; ++mi) { af[1][mi] = *(const LAS bf16x8*)(lds + st_cur + a1 + mi * 2048); }
            __builtin_amdgcn_sched_barrier(0);
            __builtin_amdgcn_s_setprio(1);
#pragma unroll
            for (int s = 0; s < 2; ++s)
#pragma unroll
                for (int mi = 0; mi < 4; ++mi)
#pragma unroll
                    for (int ni = 0; ni < 2; ++ni) acc[mi][ni] = MFMA32(bfr[s][ni], af[s][mi], acc[mi][ni]);
            __builtin_amdgcn_s_setprio(0);
            __builtin_amdgcn_sched_barrier(0);
        }
        asm volatile("s_waitcnt vmcnt(6)" ::: "memory");
        __builtin_amdgcn_s_barrier();
        asm volatile("" ::: "memory");
        { const int t_ = st_cur; st_cur = st_nxt; st_nxt = st_wr; st_wr = t_; }
    }
    asm volatile("s_waitcnt vmcnt(0)" ::: "memory");
    __builtin_amdgcn_s_barrier();
    asm volatile("" ::: "memory");
#undef G5_ISSUE
    if constexpr (Epi::STAGED == 1) {
        epi.template staged<4>(acc, m0 + 128 * wm, n0 + 64 * wn, r, h, ldsg + wave * (32 * 68 * 4), lane);
        __builtin_amdgcn_s_barrier();
        asm volatile("" ::: "memory");
    } else if constexpr (Epi::STAGED == 2) {
        epi.template stage<4>(acc, wm, wn, m0, n0, r, h, ldsg);
        __syncthreads();
        epi.flush(m0, n0, tid, ldsg);
        __syncthreads();
    } else {
        epi.template operator()<4>(acc, m0 + 128 * wm, n0 + 64 * wn, r, h);
    }
}

template <int GW>
DI void tile_of(int lt, int nmx, int ntiles, int& mj, int& n) {
    const int gsz = nmx * GW, g = lt / gsz, rem = lt - g * gsz;
    const int w = (ntiles - GW * g) < GW ? (ntiles - GW * g) : GW;
    mj = rem / w; n = GW * g + rem - mj * w;
}
template <class Epi>
DI void gemm_phase4(unsigned char* lds, const u16* A, int lda, const u16* Bt, int ldb, int K, int mtiles, int ntiles, const Epi& epi) {
    const int G = gridDim.x;
    if ((G & 7) == 0) {
        const int xcd = blockIdx.x & 7, local = blockIdx.x >> 3, nlocal = G >> 3;
        const int nmx = (mtiles - xcd + 7) >> 3, total = nmx * ntiles;
        for (int lt = local; lt < total; lt += nlocal) { int mj, n; tile_of<8>(lt, nmx, ntiles, mj, n); gemm_tile5(lds, A, lda, Bt, ldb, K, (xcd + 8 * mj) * 256, n * 128, epi); }
    } else {
        for (int t = blockIdx.x; t < mtiles * ntiles; t += G) gemm_tile5(lds, A, lda, Bt, ldb, K, (t / ntiles) * 256, (t % ntiles) * 128, epi);
    }
}

struct EpiProj {
    static constexpr int STAGED = 2;
    static constexpr int ROWB = 272;
    u16* proj; const float* ropec; const float* ropes;
    template <int MI> DI void stage(const f32x16 (&acc)[MI][2], int wm, int wn, int m0, int n0, int r, int h, unsigned char* lds) const {
        const int nb = n0 + 64 * wn;
        const bool isq = nb >= C_Q && nb < C_K, isk = nb >= C_K && nb < C_V;
        const float qs = isq ? 0.125f * LOG2E : 1.f;
#pragma unroll
        for (int mi = 0; mi < MI; ++mi) {
            const int rl = 128 * wm + 32 * mi + r, row = m0 + rl;
            const bool rope = (isq || isk) && row < MLAT;
            const int t = row & (SEQ - 1);
#pragma unroll
            for (int ni = 0; ni < 2; ++ni) {
                float lo[8], hi[8];
#pragma unroll
                for (int j = 0; j < 8; ++j) { lo[j] = acc[mi][ni][j]; hi[j] = acc[mi][ni][8 + j]; }
                if (rope) {
                    const int pos = ni == 0 ? (t >> 6) : (t & 63);
                    const float* cp = ropec + pos * 16 + 8 * h; const float* sp = ropes + pos * 16 + 8 * h;
#pragma unroll
                    for (int j = 0; j < 8; ++j) { const float c = cp[j], s = sp[j], x1 = lo[j], x2 = hi[j]; lo[j] = x1 * c - x2 * s; hi[j] = x2 * c + x1 * s; }
                }
                if (isq) {
#pragma unroll
                    for (int j = 0; j < 8; ++j) { lo[j] *= qs; hi[j] *= qs; }
                }
                unsigned char* d = lds + rl * ROWB + (64 * wn + 32 * ni + 8 * h) * 2;
                *(u32x4*)d = pack8(lo); *(u32x4*)(d + 32) = pack8(hi);
            }
        }
    }
    DI void flush(int m0, int n0, int tid, const unsigned char* lds) const {
#pragma unroll
        for (int k = 0; k < 16; ++k) {
            const int id = tid + 256 * k, row = id >> 4, c = id & 15;
            const u32x4 v = *(const u32x4*)(lds + row * ROWB + c * 16);
            if (n0 + 8 * c < NIN) *(u32x4*)(proj + (size_t)(m0 + row) * NIN + n0 + 8 * c) = v;
        }
    }
    template <int MI> DI void operator()(const f32x16 (&acc)[MI][2], int mb, int nb, int r, int h) const {
        const bool isq = nb >= C_Q && nb < C_K, isk = nb >= C_K && nb < C_V;
        const float qs = isq ? 0.125f * LOG2E : 1.f;
#pragma unroll
        for (int mi = 0; mi < MI; ++mi) {
            const int row = mb + 32 * mi + r;
            u16* rp = proj + (size_t)row * NIN;
            const bool rope = (isq || isk) && row < MLAT;
            const int t = row & (SEQ - 1);
#pragma unroll
            for (int ni = 0; ni < 2; ++ni) {
                float lo[8], hi[8];
#pragma unroll
                for (int j = 0; j < 8; ++j) { lo[j] = acc[mi][ni][j]; hi[j] = acc[mi][ni][8 + j]; }
                if (rope) {
                    const int pos = ni == 0 ? (t >> 6) : (t & 63);
                    const float* cp = ropec + pos * 16 + 8 * h; const float* sp = ropes + pos * 16 + 8 * h;
#pragma unroll
                    for (int j = 0; j < 8; ++j) { const float c = cp[j], s = sp[j], x1 = lo[j], x2 = hi[j]; lo[j] = x1 * c - x2 * s; hi[j] = x2 * c + x1 * s; }
                }
                if (isq) {
#pragma unroll
                    for (int j = 0; j < 8; ++j) { lo[j] *= qs; hi[j] *= qs; }
                }
                const int n = nb + 32 * ni + 8 * h;
                if (n < NIN) *(u32x4*)(rp + n) = pack8(lo);
                if (n + 16 < NIN) *(u32x4*)(rp + n + 16) = pack8(hi);
            }
        }
    }
};
struct EpiResid {
    static constexpr int STAGED = 1;
    const float* src_lat; const float* src_ctx; float* dst_lat; float* dst_ctx; const float* gate;
    template <int MI> DI void staged(const f32x16 (&acc)[MI][2], int mb, int nb, int r, int h, unsigned char* wl, int lane) const {
        const int var = mb < SEQ ? 0 : (mb < MLAT ? 1 : 2);
        const int rr = lane >> 4, c4 = (lane & 15) * 4;
        const f32x4 gt = *(const f32x4*)(gate + var * 6 * D + nb + c4);
        float* W = (float*)wl;
        f32x4 xs[2][8];
#pragma unroll
        for (int s = 0; s < 2; ++s)
#pragma unroll
            for (int it = 0; it < 8; ++it) {
                const int row = mb + 32 * s + 4 * it + rr;
                const float* sp = row < MLAT ? src_lat + (size_t)row * D : src_ctx + (size_t)(row - MLAT) * D;
                xs[s][it] = *(const f32x4*)(sp + nb + c4);
            }
#pragma unroll
        for (int mi = 0; mi < MI; ++mi) {
#pragma unroll
            for (int ni = 0; ni < 2; ++ni)
#pragma unroll
                for (int g = 0; g < 2; ++g) {
                    float* d = W + r * 68 + 32 * ni + 16 * g + 8 * h;
                    f32x4 v0, v1;
                    v0.x = acc[mi][ni][8 * g]; v0.y = acc[mi][ni][8 * g + 1]; v0.z = acc[mi][ni][8 * g + 2]; v0.w = acc[mi][ni][8 * g + 3];
                    v1.x = acc[mi][ni][8 * g + 4]; v1.y = acc[mi][ni][8 * g + 5]; v1.z = acc[mi][ni][8 * g + 6]; v1.w = acc[mi][ni][8 * g + 7];
                    *(f32x4*)d = v0; *(f32x4*)(d + 4) = v1;
                }
            asm volatile("s_waitcnt lgkmcnt(0)" ::: "memory");
#pragma unroll
            for (int it = 0; it < 8; ++it) {
                const int rl = 4 * it + rr, row = mb + 32 * mi + rl;
                const f32x4 a = *(const f32x4*)(W + rl * 68 + c4);
                float* dp = row < MLAT ? dst_lat + (size_t)row * D : dst_ctx + (size_t)(row - MLAT) * D;
                const f32x4 s = xs[mi & 1][it];
                f32x4 o; o.x = s.x + gt.x * a.x; o.y = s.y + gt.y * a.y; o.z = s.z + gt.z * a.z; o.w = s.w + gt.w * a.w;
                *(f32x4*)(dp + nb + c4) = o;
            }
            asm volatile("s_waitcnt lgkmcnt(0)" ::: "memory");
            if (mi + 2 < MI) {
#pragma unroll
                for (int it = 0; it < 8; ++it) {
                    const int row = mb + 32 * (mi + 2) + 4 * it + rr;
                    const float* sp = row < MLAT ? src_lat + (size_t)row * D : src_ctx + (size_t)(row - MLAT) * D;
                    xs[mi & 1][it] = *(const f32x4*)(sp + nb + c4);
                }
            }
        }
    }
    template <int MI> DI void operator()(const f32x16 (&acc)[MI][2], int mb, int nb, int r, int h) const {
        const int var = mb < SEQ ? 0 : (mb < MLAT ? 1 : 2);
        const float* gv = gate + var * 6 * D;
#pragma unroll
        for (int mi = 0; mi < MI; ++mi) {
            const int row = mb + 32 * mi + r;
            const float* sp = row < MLAT ? src_lat + (size_t)row * D : src_ctx + (size_t)(row - MLAT) * D;
            float* dp = row < MLAT ? dst_lat + (size_t)row * D : dst_ctx + (size_t)(row - MLAT) * D;
#pragma unroll
            for (int ni = 0; ni < 2; ++ni)
#pragma unroll
                for (int g = 0; g < 2; ++g) {
                    const int n = nb + 32 * ni + 16 * g + 8 * h;
#pragma unroll
                    for (int q = 0; q < 2; ++q) {
                        const f32x4 s = *(const f32x4*)(sp + n + 4 * q), gt = *(const f32x4*)(gv + n + 4 * q);
                        f32x4 o; o.x = s.x + gt.x * acc[mi][ni][8 * g + 4 * q]; o.y = s.y + gt.y * acc[mi][ni][8 * g + 4 * q + 1];
                        o.z = s.z + gt.z * acc[mi][ni][8 * g + 4 * q + 2]; o.w = s.w + gt.w * acc[mi][ni][8 * g + 4 * q + 3];
                        *(f32x4*)(dp + n + 4 * q) = o;
                    }
                }
        }
    }
};
struct EpiPartial {
    float* part;
    template <int MI> DI void operator()(const f32x16 (&acc)[MI][2], int mb, int nb, int r, int h) const {
#pragma unroll
        for (int mi = 0; mi < MI; ++mi) {
            float* dp = part + (size_t)(mb + 32 * mi + r - MLAT) * D;
#pragma unroll
            for (int ni = 0; ni < 2; ++ni)
#pragma unroll
                for (int g = 0; g < 2; ++g) {
                    const int n = nb + 32 * ni + 16 * g + 8 * h;
                    f32x4 v0, v1;
                    v0.x = acc[mi][ni][8 * g]; v0.y = acc[mi][ni][8 * g + 1]; v0.z = acc[mi][ni][8 * g + 2]; v0.w = acc[mi][ni][8 * g + 3];
                    v1.x = acc[mi][ni][8 * g + 4]; v1.y = acc[mi][ni][8 * g + 5]; v1.z = acc[mi][ni][8 * g + 6]; v1.w = acc[mi][ni][8 * g + 7];
                    *(f32x4*)(dp + n) = v0; *(f32x4*)(dp + n + 4) = v1;
                }
        }
    }
};
struct EpiSwiglu {
    static constexpr int STAGED = 2;
    static constexpr int ROWB = 144;
    u16* hb;
    template <int MI> DI void stage(const f32x16 (&acc)[MI][2], int wm, int wn, int m0, int n0, int r, int h, unsigned char* lds) const {
#pragma unroll
        for (int mi = 0; mi < MI; ++mi) {
            const int rl = 128 * wm + 32 * mi + r;
#pragma unroll
            for (int g = 0; g < 2; ++g) {
                float f[8];
#pragma unroll
                for (int j = 0; j < 8; ++j) f[j] = siluf(acc[mi][0][8 * g + j]) * acc[mi][1][8 * g + j];
                *(u32x4*)(lds + rl * ROWB + (32 * wn + 16 * g + 8 * h) * 2) = pack8(f);
            }
        }
    }
    DI void flush(int m0, int n0, int tid, const unsigned char* lds) const {
#pragma unroll
        for (int k = 0; k < 8; ++k) {
            const int id = tid + 256 * k, row = id >> 3, c = id & 7;
            *(u32x4*)(hb + (size_t)(m0 + row) * DFF + (n0 >> 1) + 8 * c) = *(const u32x4*)(lds + row * ROWB + c * 16);
        }
    }
    template <int MI> DI void operator()(const f32x16 (&acc)[MI][2], int mb, int nb, int r, int h) const {
#pragma unroll
        for (int mi = 0; mi < MI; ++mi) {
            u16* rp = hb + (size_t)(mb + 32 * mi + r) * DFF + (nb >> 1);
#pragma unroll
            for (int g = 0; g < 2; ++g) {
                float f[8];
#pragma unroll
                for (int j = 0; j < 8; ++j) f[j] = siluf(acc[mi][0][8 * g + j]) * acc[mi][1][8 * g + j];
                *(u32x4*)(rp + 16 * g + 8 * h) = pack8(f);
            }
        }
    }
};

DI void attn_unit(unsigned char* lds, const Params& p, int l, int u) {
    const u16* proj = (const u16*)(p.ws + OFF_PROJ);
    u16* cat = (u16*)(p.ws + OFF_CAT);
    const float* ropec = (const float*)(p.ws + OFF_ROPE);
    const float* ropes = ropec + 4096;
    u16* Ks = (u16*)lds; u16* Vt = (u16*)(lds + T64_B);
    const int tid = otid(), lane = tid & 63, wave = tid >> 6, r = lane & 31, h = lane >> 5;
    const bool isctx = u >= 2048;
    int b, hd, qb;
    if (!isctx) { qb = u & 127; hd = (u >> 7) & 7; b = u >> 10; } else { const int cu = u - 2048; qb = cu & 1; hd = (cu >> 1) & 7; b = cu >> 4; }
    const int kvh = hd >> 2;
    const int q0 = 128 * qb + 32 * wave;
    const size_t qrow = (size_t)(isctx ? MLAT + b * CTX : b * SEQ) + q0 + r;
    bf16x8 qf[4];
#pragma unroll
    for (int s = 0; s < 4; ++s) qf[s] = __builtin_bit_cast(bf16x8, *(const u32x4*)(proj + qrow * NIN + C_Q + hd * 64 + 16 * s + 8 * h));
    float m = p.sink[l * 8 + hd] * LOG2E;
    float lsum = (h == 0) ? 1.f : 0.f;
    f32x16 O0 = zero16(), O1 = zero16();
    const int ntiles = isctx ? 4 : 10;
    for (int tile = 0; tile < ntiles; ++tile) {
        const bool local = tile >= 4;
        int tk0 = 0; size_t krow0;
        if (!local) krow0 = (size_t)MLAT + b * CTX + 64 * tile;
        else { tk0 = 128 * qb - 128 + 64 * (tile - 4); if (tk0 < 0 || tk0 >= SEQ) continue; krow0 = (size_t)b * SEQ + tk0; }
        __syncthreads();
        {
            const int key = tid >> 2, part = tid & 3, half = part >> 1, sub = part & 1;
            const u16* kp = proj + (krow0 + key) * NIN + C_K + kvh * 64 + 32 * half + 8 * sub;
            u32x4 w1 = *(const u32x4*)kp, w2 = *(const u32x4*)(kp + 16);
            *(u32x4*)(Ks + key * LROW + 32 * half + 8 * sub) = w1;
            *(u32x4*)(Ks + key * LROW + 32 * half + 16 + 8 * sub) = w2;
        }
        {
            const int key = tid & 63, dc = tid >> 6;
            const u16* vp = proj + (krow0 + key) * NIN + C_V + kvh * 64 + 16 * dc;
            const u32x4 v0 = *(const u32x4*)vp, v1 = *(const u32x4*)(vp + 8);
            const unsigned wv[8] = {v0.x, v0.y, v0.z, v0.w, v1.x, v1.y, v1.z, v1.w};
#pragma unroll
            for (int i = 0; i < 8; ++i) { Vt[(16 * dc + 2 * i) * LROW + key] = (u16)(wv[i] & 0xffffu); Vt[(16 * dc + 2 * i + 1) * LROW + key] = (u16)(wv[i] >> 16); }
        }
        __syncthreads();
        if (local && (tk0 + 63 < q0 - 128 || tk0 > q0 + 31 + 128)) continue;
        const bool needmask = local && !(tk0 >= q0 + 31 - 128 && tk0 + 63 <= q0 + 128);
#pragma unroll
        for (int sub = 0; sub < 2; ++sub) {
            f32x16 s0 = zero16();
#pragma unroll
            for (int s = 0; s < 4; ++s) {
                const bf16x8 ka0 = *(const bf16x8*)(Ks + (32 * sub + pi32(r)) * LROW + 16 * s + 8 * h);
                s0 = MFMA32(ka0, qf[s], s0);
            }
            if (needmask) {
                const int tq = q0 + r;
#pragma unroll
                for (int i = 0; i < 16; ++i) {
                    const int tk = tk0 + 32 * sub + 16 * (i >> 3) + 8 * h + (i & 7);
                    const int d0 = tq - tk;
                    if (d0 > 128 || d0 < -128) s0[i] = -INFINITY;
                }
            }
            float mx = s0[0];
#pragma unroll
            for (int i = 1; i < 16; ++i) mx = fmaxf(mx, s0[i]);
            mx = fmaxf(mx, __shfl_xor(mx, 32));
            const float mn = fmaxf(m, mx);
            const float alpha = __builtin_amdgcn_exp2f(m - mn);
            m = mn;
            float ps = 0.f;
#pragma unroll
            for (int i = 0; i < 16; ++i) { s0[i] = __builtin_amdgcn_exp2f(s0[i] - mn); ps += s0[i]; }
            lsum = lsum * alpha + ps;
            if (__builtin_amdgcn_ballot_w64(alpha != 1.f) != 0ull) {
#pragma unroll
                for (int i = 0; i < 16; ++i) { O0[i] *= alpha; O1[i] *= alpha; }
            }
            bf16x8 pf[2];
            {
                u32x4 w;
                w.x = pk2(s0[0], s0[1]); w.y = pk2(s0[2], s0[3]); w.z = pk2(s0[4], s0[5]); w.w = pk2(s0[6], s0[7]); pf[0] = __builtin_bit_cast(bf16x8, w);
                w.x = pk2(s0[8], s0[9]); w.y = pk2(s0[10], s0[11]); w.z = pk2(s0[12], s0[13]); w.w = pk2(s0[14], s0[15]); pf[1] = __builtin_bit_cast(bf16x8, w);
            }
#pragma unroll
            for (int ks = 0; ks < 2; ++ks) {
                const bf16x8 va0 = *(const bf16x8*)(Vt + r * LROW + 32 * sub + 16 * ks + 8 * h);
                const bf16x8 va1 = *(const bf16x8*)(Vt + (32 + r) * LROW + 32 * sub + 16 * ks + 8 * h);
                O0 = MFMA32(va0, pf[ks], O0); O1 = MFMA32(va1, pf[ks], O1);
            }
        }
    }
    const float lt = lsum + __shfl_xor(lsum, 32);
    const float inv = 1.f / lt;
    {
        unsigned char* patch = lds + 20480 + wave * (32 * 144);
#pragma unroll
        for (int g4 = 0; g4 < 4; ++g4) {
            u32x2 w0, w1;
            w0.x = pk2(O0[4 * g4] * inv, O0[4 * g4 + 1] * inv); w0.y = pk2(O0[4 * g4 + 2] * inv, O0[4 * g4 + 3] * inv);
            w1.x = pk2(O1[4 * g4] * inv, O1[4 * g4 + 1] * inv); w1.y = pk2(O1[4 * g4 + 2] * inv, O1[4 * g4 + 3] * inv);
            *(u32x2*)(patch + r * 144 + (8 * g4 + 4 * h) * 2) = w0;
            *(u32x2*)(patch + r * 144 + (32 + 8 * g4 + 4 * h) * 2) = w1;
        }
        asm volatile("s_waitcnt lgkmcnt(0)" ::: "memory");
        u16* ob = cat + (qrow - r) * D + 256 + hd * 64;
#pragma unroll
        for (int it = 0; it < 4; ++it) {
            const int row = 8 * it + (lane >> 3), c = lane & 7;
            *(u32x4*)(ob + (size_t)row * D + 8 * c) = *(const u32x4*)(patch + row * 144 + c * 16);
        }
        asm volatile("s_waitcnt lgkmcnt(0)" ::: "memory");
    }
}

DI void conv_unit(const Params& p, int l, int u) {
    const u16* proj = (const u16*)(p.ws + OFF_PROJ);
    u16* cat = (u16*)(p.ws + OFF_CAT);
    const float* cw = p.conv_w + l * 3 * 256;
    const int tid = otid();
#pragma unroll
    for (int i = 0; i < 4; ++i) {
        const int item = tid + 256 * i, rr = item >> 5, ch = (item & 31) * 8;
        const int row = 32 * u + rr;
        int t, len;
        if (row < MLAT) { t = row & (SEQ - 1); len = SEQ; } else { t = (row - MLAT) & (CTX - 1); len = CTX; }
        const u16* rp = proj + (size_t)row * NIN;
        float y[8];
#pragma unroll
        for (int j = 0; j < 8; ++j) y[j] = 0.f;
#pragma unroll
        for (int tap = 0; tap < 3; ++tap) {
            const int tt = t + tap - 1;
            if (tt >= 0 && tt < len) {
                const u16* np_ = rp + (ptrdiff_t)(tap - 1) * NIN;
                float xi[8], cg_[8]; unpack8(*(const u32x4*)(np_ + C_CX + ch), xi); unpack8(*(const u32x4*)(np_ + C_CC + ch), cg_);
                const f32x4 wa = *(const f32x4*)(cw + tap * 256 + ch), wb2 = *(const f32x4*)(cw + tap * 256 + ch + 4);
                const float w8[8] = {wa.x, wa.y, wa.z, wa.w, wb2.x, wb2.y, wb2.z, wb2.w};
#pragma unroll
                for (int j = 0; j < 8; ++j) y[j] += w8[j] * (cg_[j] * xi[j]);
            }
        }
        float bg[8]; unpack8(*(const u32x4*)(rp + C_CB + ch), bg);
#pragma unroll
        for (int j = 0; j < 8; ++j) y[j] *= bg[j];
        *(u32x4*)(cat + (size_t)row * D + ch) = pack8(y);
    }
}

constexpr int GL_G = 0, GL_LR = 16384, GL_GW = 20480, GL_GB = 24576, GL_QS = 24832, GL_BL = 25856, GL_T0 = 26112;
static_assert(GL_T0 + 5 * T64_B <= LDS_BYTES, "gla lds");

struct GateRegs { bf16x8 lrf; bf16x8 gwf; float gb; };
DI GateRegs gla_gate_load(const Params& p, int l, int dir, int hh, size_t row0, int tid) {
    const u16* proj = (const u16*)(p.ws + OFF_PROJ);
    const int lane = tid & 63, wave = tid >> 6, ti = wave >> 1, tj = wave & 1, r = lane & 31, h = lane >> 5;
    GateRegs g;
    g.lrf = __builtin_bit_cast(bf16x8, *(const u32x4*)(proj + (row0 + 32 * ti + r) * NIN + C_LR + 16 * dir + 8 * h));
    const float* gw = p.gate_w + ((size_t)(l * 2 + dir) * 16 + 8 * h) * 256 + hh * 64 + 32 * tj + r;
    float f[8];
#pragma unroll
    for (int j = 0; j < 8; ++j) f[j] = gw[j * 256];
    g.gwf = __builtin_bit_cast(bf16x8, pack8(f));
    g.gb = p.gate_b[(l * 2 + dir) * 256 + hh * 64 + 32 * tj + r];
    return g;
}
DI void gla_gates(unsigned char* lds, const GateRegs& gr, int dir) {
    float* G = (float*)(lds + GL_G); float* QS = (float*)(lds + GL_QS); float* BL = (float*)(lds + GL_BL);
    const int tid = otid();
    {
        const int lane = tid & 63, wave = tid >> 6, ti = wave >> 1, tj = wave & 1, r = lane & 31, h = lane >> 5;
        const f32x16 x = MFMA32(gr.lrf, gr.gwf, zero16());
#pragma unroll
        for (int i = 0; i < 16; ++i) {
            const float v = x[i] + gr.gb;
            const float ls = fminf(v, 0.f) - __logf(1.f + __expf(-fabsf(v)));
            G[(32 * ti + crow(i, h)) * 64 + 32 * tj + r] = ls * (1.f / 16.f);
        }
    }
    __syncthreads();
    const int k = tid & 63, q = tid >> 6;
    float run = 0.f;
#pragma unroll 4
    for (int i = 0; i < 16; ++i) {
        const int t = dir ? (16 * q + 15 - i) : (16 * q + i);
        run += G[t * 64 + k];
        G[t * 64 + k] = run;
    }
    QS[q * 64 + k] = run;
    __syncthreads();
    float off = 0.f, tot = 0.f;
#pragma unroll
    for (int q2 = 0; q2 < 4; ++q2) { const float v = QS[q2 * 64 + k]; tot += v; if (dir ? (q2 > q) : (q2 < q)) off += v; }
#pragma unroll 4
    for (int i = 0; i < 16; ++i) G[(16 * q + i) * 64 + k] += off;
    if (q == 0) BL[k] = tot;
    __syncthreads();
}

DI void gla_passA_unit(unsigned char* lds, const Params& p, int l, int u) {
    const u16* proj = (const u16*)(p.ws + OFF_PROJ);
    float* GST = (float*)(p.ws + OFF_GST); float* GD = (float*)(p.ws + OFF_GD);
    const float* G = (const float*)(lds + GL_G); const float* BL = (const float*)(lds + GL_BL);
    u16* VT = (u16*)(lds + GL_T0); u16* KT = (u16*)(lds + GL_T0 + T64_B);
    const int tid = otid(), lane = tid & 63, wave = tid >> 6, r = lane & 31, h = lane >> 5;
    const int dir = u & 1, hh = (u >> 1) & 3, cc = u >> 3, b = cc / NCH, jj = cc % NCH;
    const bool isctx = jj < 4; const int j = isctx ? jj : jj - 4;
    const size_t row0 = isctx ? (size_t)MLAT + b * CTX + 64 * j : (size_t)b * SEQ + 64 * j;
    const int c = isctx ? (dir ? 3 - j : j) : 4 + (dir ? 255 - j : j);
    const int seq = (b * 4 + hh) * 2 + dir;
    const GateRegs gr = gla_gate_load(p, l, dir, hh, row0, tid);
    u32x4 kA0, kA1, v0, v1;
    {
        const int tok = tid >> 2, part = tid & 3;
        const u16* kp = proj + (row0 + tok) * NIN + C_GK + hh * 64 + 16 * part;
        const u16* vp = proj + (row0 + tok) * NIN + C_GV + hh * 64 + 16 * part;
        kA0 = *(const u32x4*)kp; kA1 = *(const u32x4*)(kp + 8); v0 = *(const u32x4*)vp; v1 = *(const u32x4*)(vp + 8);
    }
    __syncthreads();
    gla_gates(lds, gr, dir);
    {
        const int tok = tid >> 2, part = tid & 3;
        float kf[16]; { float t0[8], t1[8]; unpack8(kA0, t0); unpack8(kA1, t1);
#pragma unroll
            for (int i = 0; i < 8; ++i) { kf[i] = t0[i]; kf[8 + i] = t1[i]; } }
        const unsigned wv[8] = {v0.x, v0.y, v0.z, v0.w, v1.x, v1.y, v1.z, v1.w};
#pragma unroll
        for (int i = 0; i < 16; ++i) {
            const int kk = 16 * part + i;
            const float e = __expf(BL[kk] - G[tok * 64 + kk]);
            KT[kk * LROW + tok] = f2bf(kf[i] * e);
            VT[kk * LROW + tok] = (u16)((i & 1) ? (wv[i >> 1] >> 16) : (wv[i >> 1] & 0xffffu));
        }
    }
    __syncthreads();
    const int ti = wave >> 1, tj = wave & 1;
    f32x16 acc = zero16();
#pragma unroll
    for (int s = 0; s < 4; ++s) {
        const bf16x8 a = *(const bf16x8*)(KT + (32 * ti + r) * LROW + 16 * s + 8 * h);
        const bf16x8 bb = *(const bf16x8*)(VT + (32 * tj + r) * LROW + 16 * s + 8 * h);
        acc = MFMA32(a, bb, acc);
    }
    float* st = GST + ((size_t)seq * NCH + c) * 4096;
#pragma unroll
    for (int i = 0; i < 16; ++i) st[(32 * ti + crow(i, h)) * 64 + 32 * tj + r] = acc[i];
    if (tid < 64) GD[((size_t)seq * NCH + c) * 64 + tid] = __expf(BL[tid]);
}

DI void gla_scan_phase(const Params& p) {
    float* GST = (float*)(p.ws + OFF_GST); const float* GD = (const float*)(p.ws + OFF_GD);
    const int tid = otid();
    for (int g = blockIdx.x * 256 + tid; g < 16 * 4096; g += gridDim.x * 256) {
        const int seq = g >> 12, e = g & 4095, dk = e >> 6;
        float* st = GST + (size_t)seq * NCH * 4096 + e;
        const float* gd = GD + (size_t)seq * NCH * 64 + dk;
        float S = 0.f;
        for (int c0 = 0; c0 < NCH; c0 += 20) {
            float uu[20], dd[20];
#pragma unroll
            for (int i = 0; i < 20; ++i) { uu[i] = st[(size_t)(c0 + i) * 4096]; dd[i] = gd[(c0 + i) * 64]; }
#pragma unroll
            for (int i = 0; i < 20; ++i) { st[(size_t)(c0 + i) * 4096] = S; S = dd[i] * S + uu[i]; }
        }
    }
}

DI void gla_passC_unit(unsigned char* lds, const Params& p, int l, int u) {
    const u16* proj = (const u16*)(p.ws + OFF_PROJ);
    u16* cat = (u16*)(p.ws + OFF_CAT);
    const float* GST = (const float*)(p.ws + OFF_GST);
    float* G = (float*)(lds + GL_G); const float* BL = (const float*)(lds + GL_BL);
    u16* VT = (u16*)(lds + GL_T0); u16* QT = (u16*)(lds + GL_T0 + T64_B); u16* KK = (u16*)(lds + GL_T0 + 2 * T64_B);
    u16* QB = (u16*)(lds + GL_T0 + 3 * T64_B); u16* SST = (u16*)(lds + GL_T0 + 4 * T64_B); u16* AM = QT;
    const int tid = otid(), lane = tid & 63, wave = tid >> 6, r = lane & 31, h = lane >> 5;
    const int hh = u & 3, cc = u >> 2, b = cc / NCH, jj = cc % NCH;
    const bool isctx = jj < 4; const int j = isctx ? jj : jj - 4;
    if (l == DEPTH - 1 && isctx) return;
    const size_t row0 = isctx ? (size_t)MLAT + b * CTX + 64 * j : (size_t)b * SEQ + 64 * j;
    GateRegs grd[2]; u32x4 qr[2], kr[2], v0, v1, ggr[2]; f32x4 sin_[2][4];
    {
        const int tok = tid >> 2, part = tid & 3;
        const u16* rp = proj + (row0 + tok) * NIN + hh * 64 + 16 * part;
        grd[0] = gla_gate_load(p, l, 0, hh, row0, tid); grd[1] = gla_gate_load(p, l, 1, hh, row0, tid);
        qr[0] = *(const u32x4*)(rp + C_GQ); qr[1] = *(const u32x4*)(rp + C_GQ + 8);
        kr[0] = *(const u32x4*)(rp + C_GK); kr[1] = *(const u32x4*)(rp + C_GK + 8);
        v0 = *(const u32x4*)(rp + C_GV); v1 = *(const u32x4*)(rp + C_GV + 8);
        ggr[0] = *(const u32x4*)(rp + C_GG); ggr[1] = *(const u32x4*)(rp + C_GG + 8);
        const int dk = tid >> 2, dvc = (tid & 3) * 16;
#pragma unroll
        for (int d = 0; d < 2; ++d) {
            const int c = isctx ? (d ? 3 - j : j) : 4 + (d ? 255 - j : j);
            const float* sp = GST + ((size_t)((b * 4 + hh) * 2 + d) * NCH + c) * 4096 + dk * 64 + dvc;
#pragma unroll
            for (int q4 = 0; q4 < 4; ++q4) sin_[d][q4] = *(const f32x4*)(sp + 4 * q4);
        }
    }
    __syncthreads();
    {
        const int tok = tid >> 2, part = tid & 3;
        const unsigned wv[8] = {v0.x, v0.y, v0.z, v0.w, v1.x, v1.y, v1.z, v1.w};
#pragma unroll
        for (int i = 0; i < 16; ++i) VT[(16 * part + i) * LROW + tok] = (u16)((i & 1) ? (wv[i >> 1] >> 16) : (wv[i >> 1] & 0xffffu));
    }
    const int ti = wave >> 1, tj = wave & 1;
    f32x16 o = zero16();
#pragma unroll
    for (int dir = 0; dir < 2; ++dir) {
        gla_gates(lds, grd[dir], dir);
        {
            const int tok = tid >> 2, part = tid & 3;
#pragma unroll
            for (int hf = 0; hf < 2; ++hf) {
                float qv[8], kv[8], a[8], bq[8], ck[8];
                unpack8(qr[hf], qv); unpack8(kr[hf], kv);
#pragma unroll
                for (int i = 0; i < 8; ++i) {
                    const int kk = 16 * part + 8 * hf + i;
                    const float bt = G[tok * 64 + kk], mm = 0.5f * BL[kk], qq = qv[i] * 0.125f;
                    a[i] = qq * __expf(bt - mm); ck[i] = kv[i] * __expf(mm - bt); bq[i] = qq * __expf(bt);
                }
                *(u32x4*)(QT + tok * LROW + 16 * part + 8 * hf) = pack8(a);
                *(u32x4*)(KK + tok * LROW + 16 * part + 8 * hf) = pack8(ck);
                *(u32x4*)(QB + tok * LROW + 16 * part + 8 * hf) = pack8(bq);
            }
            const int dk = tid >> 2, dvc = (tid & 3) * 16;
#pragma unroll
            for (int q4 = 0; q4 < 4; ++q4) { const f32x4 sv = sin_[dir][q4];
                SST[(dvc + 4 * q4 + 0) * LROW + dk] = f2bf(sv.x); SST[(dvc + 4 * q4 + 1) * LROW + dk] = f2bf(sv.y);
                SST[(dvc + 4 * q4 + 2) * LROW + dk] = f2bf(sv.z); SST[(dvc + 4 * q4 + 3) * LROW + dk] = f2bf(sv.w); }
        }
        __syncthreads();
        f32x16 am = zero16();
#pragma unroll
        for (int s = 0; s < 4; ++s) {
            const bf16x8 a = *(const bf16x8*)(QT + (32 * ti + r) * LROW + 16 * s + 8 * h);
            const bf16x8 bb = *(const bf16x8*)(KK + (32 * tj + r) * LROW + 16 * s + 8 * h);
            am = MFMA32(a, bb, am);
        }
        __syncthreads();
#pragma unroll
        for (int i = 0; i < 16; ++i) {
            const int t = 32 * ti + crow(i, h), s = 32 * tj + r;
            const bool keep = dir ? (s >= t) : (s <= t);
            AM[t * LROW + s] = f2bf(keep ? am[i] : 0.f);
        }
        __syncthreads();
#pragma unroll
        for (int s = 0; s < 4; ++s) {
            const bf16x8 a = *(const bf16x8*)(AM + (32 * ti + r) * LROW + 16 * s + 8 * h);
            const bf16x8 bb = *(const bf16x8*)(VT + (32 * tj + r) * LROW + 16 * s + 8 * h);
            o = MFMA32(a, bb, o);
            const bf16x8 a2 = *(const bf16x8*)(QB + (32 * ti + r) * LROW + 16 * s + 8 * h);
            const bf16x8 b2 = *(const bf16x8*)(SST + (32 * tj + r) * LROW + 16 * s + 8 * h);
            o = MFMA32(a2, b2, o);
        }
        __syncthreads();
    }
    float* OF = G;
#pragma unroll
    for (int i = 0; i < 16; ++i) OF[(32 * ti + crow(i, h)) * 64 + 32 * tj + r] = o[i];
    __syncthreads();
    {
        const int t = tid >> 2, dvc = (tid & 3) * 16;
        float ov[16]; float ss = 0.f;
#pragma unroll
        for (int q4 = 0; q4 < 4; ++q4) { const f32x4 v = *(const f32x4*)(OF + t * 64 + dvc + 4 * q4); ov[4 * q4] = v.x; ov[4 * q4 + 1] = v.y; ov[4 * q4 + 2] = v.z; ov[4 * q4 + 3] = v.w; ss += v.x * v.x + v.y * v.y + v.z * v.z + v.w * v.w; }
        ss += __shfl_xor(ss, 1); ss += __shfl_xor(ss, 2);
        const float rs = rsqrtf(ss * (1.f / 64.f) + EPS);
        const float* gn = p.gnorm + l * 64 + dvc;
        u16* op = cat + (row0 + t) * D + 768 + hh * 64 + dvc;
#pragma unroll
        for (int hf = 0; hf < 2; ++hf) {
            float gg[8], ou[8]; unpack8(ggr[hf], gg);
#pragma unroll
            for (int i = 0; i < 8; ++i) ou[i] = ov[8 * hf + i] * rs * gn[8 * hf + i] * siluf(gg[i]);
            *(u32x4*)(op + 8 * hf) = pack8(ou);
        }
    }
}

#define XB_TMO      128
#define XB_XCNT(j)  (256  + 64 * (j))
#define XB_XSUB(j)  (1280 + 64 * (j))
#define XB_XGEN(j)  (2304 + 64 * (j))
#define XB_TOP      3328
#define XB_TOPGEN   3392
#define XCD_BAR_WORDS 3456
#define XB_SPIN_CAP (1u << 18)
DI unsigned xb_ld(unsigned* p)              { return __hip_atomic_load(p, __ATOMIC_RELAXED, __HIP_MEMORY_SCOPE_AGENT); }
DI unsigned xb_add(unsigned* p, unsigned v) { return __hip_atomic_fetch_add(p, v, __ATOMIC_RELAXED, __HIP_MEMORY_SCOPE_AGENT); }
DI unsigned xb_xcc_id() { return (unsigned)__builtin_amdgcn_s_getreg((3 << 11) | 20) & 0xFu; }
#define XB_SPIN(cond, bar) do { unsigned _sp = 0; while (cond) { __builtin_amdgcn_s_sleep(1); \
    if ((++_sp & 255u) == 0u) { if (xb_ld(&(bar)[XB_TMO])) break; if (_sp > XB_SPIN_CAP) { atomicAdd(&(bar)[XB_TMO], 1u); break; } } } } while (0)
struct XcdBarrier { unsigned* bar; unsigned x; volatile LAS unsigned* st; };
DI XcdBarrier xcd_barrier_post(unsigned* bar, volatile LAS unsigned* st) {
    XcdBarrier b; b.bar = bar; b.x = xb_xcc_id(); b.st = st;
    if (threadIdx.x == 0) (void)xb_add(&bar[XB_XCNT(b.x)], 1u);
    return b;
}
DI void xcd_barrier_complete(unsigned* bar, unsigned x, unsigned& nloc, unsigned& nx) {
    const unsigned G = gridDim.x * gridDim.y * gridDim.z;
    unsigned sum, cnt, mine, sp = 0u;
    for (;;) {
        sum = 0u; cnt = 0u; mine = 0u;
#pragma unroll
        for (unsigned j = 0; j < 16; ++j) { const unsigned c = xb_ld(&bar[XB_XCNT(j)]); sum += c; cnt += (c > 0u) ? 1u : 0u; mine = (j == x) ? c : mine; }
        if (sum == G) break;
        __builtin_amdgcn_s_sleep(1);
        if ((++sp & 255u) == 0u) { if (xb_ld(&bar[XB_TMO])) break; if (sp > XB_SPIN_CAP) { atomicAdd(&bar[XB_TMO], 1u); break; } }
    }
    nloc = mine > 0u ? mine : 1u; nx = cnt > 0u ? cnt : 1u;
}
DI void xcd_barrier(const XcdBarrier& b) {
    asm volatile("s_waitcnt vmcnt(0)" ::: "memory");
    __syncthreads();
    if (threadIdx.x == 0) {
        unsigned* bar = b.bar;
        __builtin_amdgcn_s_waitcnt(0);
        unsigned nloc = b.st[0], nx = b.st[1];
        if (nloc == 0u) { xcd_barrier_complete(bar, b.x, nloc, nx); b.st[0] = nloc; b.st[1] = nx; }
        const unsigned old = xb_add(&bar[XB_XSUB(b.x)], 1u);
        const unsigned gen = old / nloc;
        if (old + 1u == (gen + 1u) * nloc) {
            __builtin_amdgcn_fence(__ATOMIC_RELEASE, "agent");
            asm volatile("s_waitcnt vmcnt(0)" ::: "memory");
            const unsigned og = xb_add(&bar[XB_TOP], 1u);
            const unsigned tg = og / nx;
            if (og + 1u == (tg + 1u) * nx) xb_add(&bar[XB_TOPGEN], 1u);
            else XB_SPIN(xb_ld(&bar[XB_TOPGEN]) == tg, bar);
            __builtin_amdgcn_fence(__ATOMIC_ACQUIRE, "agent");
            xb_add(&bar[XB_XGEN(b.x)], 1u);
            asm volatile("s_waitcnt vmcnt(0)" ::: "memory");
        } else {
            XB_SPIN(xb_ld(&bar[XB_XGEN(b.x)]) == gen, bar);
            __builtin_amdgcn_fence(__ATOMIC_ACQUIRE, "agent");
            asm volatile("s_waitcnt vmcnt(0)" ::: "memory");
        }
    }
    __syncthreads();
}

DI void ctx_splitk_phase(unsigned char* lds, const u16* A, int lda, const u16* Bt, int ldb, int K, float* part) {
    const int kq = K >> 2;
    const int G = gridDim.x;
    for (int t = G - 1 - (int)blockIdx.x; t < 128; t += G) {
        const int ks = t & 3, n = (t >> 2) & 7, mt = t >> 5;
        EpiPartial e{part + (size_t)ks * MCTX * D};
        gemm_tile(lds, A + ks * kq, lda, Bt + ks * kq, ldb, kq, MLAT + 128 * mt, n * 128, e);
    }
}

#ifndef REP_G
#define REP_G 1
#endif
#ifndef REP_M
#define REP_M 1
#endif
#ifndef REP_C
#define REP_C 1
#endif
__global__ void __launch_bounds__(256, 2) mega_fwd(Params p) {
    extern __shared__ __attribute__((aligned(16))) unsigned char lds[];
    __shared__ uint4 xb_words;
    cg::grid_group grid = cg::this_grid();
    const int G = gridDim.x;
    if (threadIdx.x == 0) xb_words = make_uint4(0u, 0u, 0u, 0u);
    __syncthreads();
    const XcdBarrier xb = xcd_barrier_post((unsigned*)(p.ws + OFF_BAR), (volatile LAS unsigned*)&xb_words);
    prologue_phase(lds, p);
    if (p.ws == nullptr) grid.sync();
    xcd_barrier(xb);
    u16* wb = (u16*)(p.ws + OFF_WB);
    u16* xn = (u16*)(p.ws + OFF_XN);
    u16* proj = (u16*)(p.ws + OFF_PROJ);
    u16* cat = (u16*)(p.ws + OFF_CAT);
    u16* hb = (u16*)(p.ws + OFF_PROJ);
    float* xc = (float*)(p.ws + OFF_XC);
    const float* mod = (const float*)(p.ws + OFF_MOD);
#pragma unroll 1
    for (int l = 0; l < DEPTH; ++l) {
        const u16* wl = wb + (size_t)l * WL_SIZE;
        const bool last = l == DEPTH - 1;
        norm_phase(p, l, 0);
        xcd_barrier(xb);
        for (int rep = 0; rep < REP_G; ++rep) {
        { EpiProj e{proj, (const float*)(p.ws + OFF_ROPE), (const float*)(p.ws + OFF_ROPE) + 4096}; gemm_phase4(lds, xn, D, wl + WL_IN, D, D, MROWS / 256, NINP / 128, e); }
        xcd_barrier(xb);
        }
        for (int rep = 0; rep < REP_M; ++rep) {
            if (rep) xcd_barrier(xb);
            const int NA = 2048 + (last ? 0 : 32), NGA = 8 * 2 * NCH, NCV = (last ? MLAT : MROWS) / 32;
            for (int u = blockIdx.x; u < NA + NGA + NCV; u += G) {
                if (u < NA) attn_unit(lds, p, l, u);
                else if (u < NA + NGA) gla_passA_unit(lds, p, l, u - NA);
                else conv_unit(p, l, u - NA - NGA);
            }
        }
        xcd_barrier(xb);
        gla_scan_phase(p);
        if (!last) weights_phase(lds, p, l + 1, (16 * 4096 / 256) % G);
        xcd_barrier(xb);
        for (int rep = 0; rep < REP_C; ++rep) {
        for (int u = blockIdx.x; u < 4 * 2 * NCH; u += G) gla_passC_unit(lds, p, l, u);
        xcd_barrier(xb);
        }
        {
            EpiResid e{l == 0 ? p.x : p.out, l == 0 ? p.ctx : xc, p.out, xc, mod + (size_t)l * 3 * 6 * D + 2 * D};
            gemm_phase4(lds, cat, D, wl + WL_OUT, D, D, MLAT / 256, D / 128, e);
            if (!last) ctx_splitk_phase(lds, cat, D, wl + WL_OUT, D, D, (float*)(p.ws + OFF_PART));
        }
        xcd_barrier(xb);
        norm_phase(p, l, 1);
        xcd_barrier(xb);
        for (int rep = 0; rep < REP_G; ++rep) {
        { EpiSwiglu e{hb}; gemm_phase4(lds, xn, D, wl + WL_UP, D, D, (last ? MLAT : MROWS) / 256, 2 * DFF / 128, e); }
        xcd_barrier(xb);
        }
        {
            EpiResid e{p.out, xc, p.out, xc, mod + (size_t)l * 3 * 6 * D + 5 * D};
            gemm_phase4(lds, hb, DFF, wl + WL_DOWN, DFF, DFF, MLAT / 256, D / 128, e);
            if (!last) ctx_splitk_phase(lds, hb, DFF, wl + WL_DOWN, DFF, DFF, (float*)(p.ws + OFF_PART));
        }
        xcd_barrier(xb);
    }
    final_norm_phase(p);
}

extern "C" void kernel_launch(void* const* d_in, const int* in_sizes, int n_in, void* d_out, int out_size, void* d_ws, size_t ws_size, hipStream_t stream) {
    static int grid_blocks = 0;
    if (!grid_blocks) {
        if (ws_size < WS_END) { fprintf(stderr, "kernel_launch: workspace too small: %zu < %zu\n", ws_size, (size_t)WS_END); grid_blocks = -1; return; }
        int dev = 0, cus = 0, per_cu = 0;
        hipGetDevice(&dev);
        hipDeviceGetAttribute(&cus, hipDeviceAttributeMultiprocessorCount, dev);
        if (hipFuncSetAttribute((const void*)mega_fwd, hipFuncAttributeMaxDynamicSharedMemorySize, LDS_BYTES) != hipSuccess) fprintf(stderr, "kernel_launch: hipFuncSetAttribute failed\n");
        hipOccupancyMaxActiveBlocksPerMultiprocessor(&per_cu, (const void*)mega_fwd, 256, LDS_BYTES);
        if (per_cu < 1) per_cu = 1;
        if (per_cu > 2) per_cu = 2;
        grid_blocks = cus * per_cu;
        fprintf(stderr, "kernel_launch: cus %d per_cu %d grid %d\n", cus, per_cu, grid_blocks);
    }
    if (grid_blocks < 0) return;
    Params p{};
    p.x = (const float*)d_in[0]; p.c = (const float*)d_in[1]; p.ctx = (const float*)d_in[2]; p.c_ctx = (const float*)d_in[3];
    p.w_mod = (const float*)d_in[4]; p.b_mod = (const float*)d_in[5]; p.g1 = (const float*)d_in[6]; p.g2 = (const float*)d_in[7];
    p.w_in = (const float*)d_in[8]; p.conv_w = (const float*)d_in[9]; p.sink = (const float*)d_in[10]; p.gate_w = (const float*)d_in[11];
    p.gate_b = (const float*)d_in[12]; p.gnorm = (const float*)d_in[13]; p.w_out = (const float*)d_in[14]; p.w_up = (const float*)d_in[15];
    p.w_down = (const float*)d_in[16]; p.gfinal = (const float*)d_in[17];
    p.out = (float*)d_out; p.ws = (unsigned char*)d_ws;
    (void)hipMemsetAsync((unsigned char*)d_ws + OFF_BAR, 0, XCD_BAR_WORDS * 4, stream);
    void* args[] = {&p};
    hipError_t e = hipLaunchCooperativeKernel((const void*)mega_fwd, dim3(grid_blocks), dim3(256), args, LDS_BYTES, stream);
    if (e != hipSuccess) fprintf(stderr, "cooperative launch failed: %s (grid %d)\n", hipGetErrorString(e), grid_blocks);
}
```
